# Optimizing an MI355X kernel written in HIP

```python
import jax, jax.numpy as jnp
from jax import lax
import numpy as np

D_MODEL = 1024
BATCH = 8
SEQ = 4096
DEPTH = 4

GRID_W = 64
CTX_LEN = 256
N_MIXERS = 3
D_FF = 2816
EPS = 1e-6
Q_BLOCK = 128
ROPE_THETA = 10000.0
N_MOD = 9

A_HEADS = 8
A_NOPE = 128
A_ROPE = 64
A_V = 128
A_Q_RANK = 384
A_KV_RANK = 256

B_HEADS = 8
B_KV_HEADS = 2
B_HEAD_DIM = 128
B_GROUP = B_HEADS // B_KV_HEADS

C_HEADS = 16
C_HEAD_DIM = 64
C_WIN_ROWS = 8
C_WIN_COLS = 16

N_A_LAYERS = (DEPTH + 2) // 3
N_B_LAYERS = (DEPTH + 1) // 3
N_C_LAYERS = DEPTH // 3

kernel_name = 'hybrid_mla_gqa_natten_macaron_prefix_dit'


def rmsnorm(x, g):
    xf = x.astype(jnp.float32)
    y = xf * lax.rsqrt(jnp.mean(xf * xf, axis=-1, keepdims=True) + EPS)
    return (y * g.astype(jnp.float32)).astype(x.dtype)


def axial_rope(rows, rot_dim):
    n = rot_dim // 4
    inv_freq = ROPE_THETA ** (-jnp.arange(n, dtype=jnp.float32) / n)
    t = jnp.arange(rows * GRID_W, dtype=jnp.int32)
    r = (t // GRID_W).astype(jnp.float32)
    col = (t % GRID_W).astype(jnp.float32)
    ang = jnp.concatenate([r[:, None] * inv_freq[None, :], col[:, None] * inv_freq[None, :]], axis=-1)
    return jnp.cos(ang), jnp.sin(ang)


def apply_rope(x, cos, sin):
    half = x.shape[-1] // 2
    xf = x.astype(jnp.float32)
    x1, x2 = xf[..., :half], xf[..., half:]
    cs, sn = cos[None, :, None, :], sin[None, :, None, :]
    return jnp.concatenate([x1 * cs - x2 * sn, x2 * cs + x1 * sn], axis=-1).astype(x.dtype)


def blocked_attention(q, k, v, scale):
    b, t, hk, g, dk = q.shape
    nb = t // Q_BLOCK
    qb = jnp.moveaxis(q.reshape(b, nb, Q_BLOCK, hk, g, dk), 1, 0)

    def one_block(qi):
        s = jnp.einsum('bqhgd,bshd->bhgqs', qi, k, preferred_element_type=jnp.float32) * scale
        p = jax.nn.softmax(s, axis=-1).astype(v.dtype)
        return jnp.einsum('bhgqs,bshd->bqhgd', p, v)

    o = lax.map(one_block, qb)
    return jnp.moveaxis(o, 0, 1).reshape(b, t, hk * g * v.shape[-1])


def half_ffn(x, g, shift, scale, gate, w13, w2):
    h = rmsnorm(x, g) * (1 + scale) + shift
    hg, hu = jnp.split(h @ w13, 2, axis=-1)
    return x + 0.5 * gate * ((jax.nn.silu(hg) * hu) @ w2)


def mla_qkv(h, w_in, q_norm_g, kv_norm_g, w_uq, w_ukv, rope, with_q):
    b, t, _ = h.shape
    if with_q:
        proj = h @ w_in
        c_q, rest = proj[..., :A_Q_RANK], proj[..., A_Q_RANK:]
    else:
        rest = h @ w_in[:, A_Q_RANK:]
    c_kv, k_r = rest[..., :A_KV_RANK], rest[..., A_KV_RANK:]
    kv = (rmsnorm(c_kv, kv_norm_g) @ w_ukv).reshape(b, t, A_HEADS, A_NOPE + A_V)
    k_nope, v = kv[..., :A_NOPE], kv[..., A_NOPE:]
    k_r = k_r[:, :, None, :]
    if rope is not None:
        k_r = apply_rope(k_r, *rope)
    k = jnp.concatenate([k_nope, jnp.broadcast_to(k_r, (b, t, A_HEADS, A_ROPE))], axis=-1)
    q = None
    if with_q:
        q = (rmsnorm(c_q, q_norm_g) @ w_uq).reshape(b, t, A_HEADS, A_NOPE + A_ROPE)
        if rope is not None:
            q = jnp.concatenate([q[..., :A_NOPE], apply_rope(q[..., A_NOPE:], *rope)], axis=-1)
    return q, k, v


def mixer_mla(h, hc, w_in, q_norm_g, kv_norm_g, w_uq, w_ukv, w_o, rope, ctx_out):
    scale = (A_NOPE + A_ROPE) ** -0.5
    q, k, v = mla_qkv(h, w_in, q_norm_g, kv_norm_g, w_uq, w_ukv, rope, True)
    qc, kc, vc = mla_qkv(hc, w_in, q_norm_g, kv_norm_g, w_uq, w_ukv, None, ctx_out)
    o_lat = blocked_attention(q[:, :, :, None], jnp.concatenate([kc, k], axis=1),
                              jnp.concatenate([vc, v], axis=1), scale) @ w_o
    o_ctx = None
    if ctx_out:
        o_ctx = blocked_attention(qc[:, :, :, None], kc, vc, scale) @ w_o
    return o_lat, o_ctx


def gqa_qkv(h, w_qkv, q_norm_g, k_norm_g, rope, with_q):
    b, t, _ = h.shape
    qw = B_HEADS * B_HEAD_DIM
    kw = B_KV_HEADS * B_HEAD_DIM
    if with_q:
        proj = h @ w_qkv
        q, rest = proj[..., :qw], proj[..., qw:]
    else:
        rest = h @ w_qkv[:, qw:]
    k = rmsnorm(rest[..., :kw].reshape(b, t, B_KV_HEADS, B_HEAD_DIM), k_norm_g)
    v = rest[..., kw:].reshape(b, t, B_KV_HEADS, B_HEAD_DIM)
    if rope is not None:
        k = apply_rope(k, *rope)
    if with_q:
        q = rmsnorm(q.reshape(b, t, B_HEADS, B_HEAD_DIM), q_norm_g)
        if rope is not None:
            q = apply_rope(q, *rope)
        q = q.reshape(b, t, B_KV_HEADS, B_GROUP, B_HEAD_DIM)
    else:
        q = None
    return q, k, v


def mixer_gqa(h, hc, w_qkv, q_norm_g, k_norm_g, w_o, rope, ctx_out):
    scale = B_HEAD_DIM ** -0.5
    q, k, v = gqa_qkv(h, w_qkv, q_norm_g, k_norm_g, rope, True)
    qc, kc, vc = gqa_qkv(hc, w_qkv, q_norm_g, k_norm_g, None, ctx_out)
    o_lat = blocked_attention(q, jnp.concatenate([kc, k], axis=1),
                              jnp.concatenate([vc, v], axis=1), scale) @ w_o
    o_ctx = None
    if ctx_out:
        o_ctx = blocked_attention(qc, kc, vc, scale) @ w_o
    return o_lat, o_ctx


def mixer_neighbourhood(h, hc, w_qkv, rpb, w_o, ctx_out):
    b, t, _ = h.shape
    rows = t // GRID_W
    kr = min(C_WIN_ROWS, rows)
    hd = C_HEADS * C_HEAD_DIM
    scale = C_HEAD_DIM ** -0.5
    proj = h @ w_qkv
    qg = proj[..., :hd].reshape(b, rows, GRID_W, C_HEADS, C_HEAD_DIM)
    kg = proj[..., hd:2 * hd].reshape(b, rows, GRID_W, C_HEADS, C_HEAD_DIM)
    vg = proj[..., 2 * hd:].reshape(b, rows, GRID_W, C_HEADS, C_HEAD_DIM)
    tc = hc.shape[1]
    if ctx_out:
        pc = hc @ w_qkv
        qc = pc[..., :hd].reshape(b, tc, C_HEADS, C_HEAD_DIM)
        pc = pc[..., hd:]
    else:
        pc = hc @ w_qkv[:, hd:]
    kc = pc[..., :hd].reshape(b, tc, C_HEADS, C_HEAD_DIM)
    vc = pc[..., hd:].reshape(b, tc, C_HEADS, C_HEAD_DIM)

    cols = jnp.arange(GRID_W, dtype=jnp.int32)
    col_start = jnp.clip(cols - C_WIN_COLS // 2, 0, GRID_W - C_WIN_COLS)
    col_idx = col_start[:, None] + jnp.arange(C_WIN_COLS, dtype=jnp.int32)[None, :]
    col_off = col_idx - cols[:, None] + (C_WIN_COLS - 1)

    def one_row(r):
        r0 = jnp.clip(r - kr // 2, 0, rows - kr)
        k_rows = lax.dynamic_slice_in_dim(kg, r0, kr, axis=1)
        v_rows = lax.dynamic_slice_in_dim(vg, r0, kr, axis=1)
        k_win = k_rows[:, :, col_idx]
        v_win = v_rows[:, :, col_idx]
        q_r = lax.dynamic_index_in_dim(qg, r, axis=1, keepdims=False)
        s_loc = jnp.einsum('bqhd,bkqwhd->bhqkw', q_r, k_win, preferred_element_type=jnp.float32) * scale
        row_off = r0 + jnp.arange(kr, dtype=jnp.int32) - r + (C_WIN_ROWS - 1)
        bias = rpb[:, row_off[:, None, None], col_off[None, :, :]]
        s_loc = s_loc + jnp.transpose(bias, (0, 2, 1, 3)).astype(jnp.float32)[None]
        s_ctx = jnp.einsum('bqhd,bchd->bhqc', q_r, kc, preferred_element_type=jnp.float32) * scale
        s = jnp.concatenate([s_ctx, s_loc.reshape(b, C_HEADS, GRID_W, kr * C_WIN_COLS)], axis=-1)
        p = jax.nn.softmax(s, axis=-1).astype(vg.dtype)
        p_ctx = p[..., :tc]
        p_loc = p[..., tc:].reshape(b, C_HEADS, GRID_W, kr, C_WIN_COLS)
        return (jnp.einsum('bhqc,bchd->bqhd', p_ctx, vc)
                + jnp.einsum('bhqkw,bkqwhd->bqhd', p_loc, v_win))

    o = lax.map(one_row, jnp.arange(rows, dtype=jnp.int32))
    o_lat = jnp.moveaxis(o, 0, 1).reshape(b, t, hd) @ w_o
    o_ctx = None
    if ctx_out:
        o_ctx = blocked_attention(qc[:, :, :, None], kc, vc, scale) @ w_o
    return o_lat, o_ctx


def _dense(k, shape, fan_in, gain=1.0):
    return jax.random.normal(k, shape, jnp.float32) * (gain * fan_in ** -0.5)


def _gain(k, shape):
    return 1.0 + 0.02 * jax.random.normal(k, shape, jnp.float32)


def setup_inputs(seed: int = 0) -> dict:
    key = jax.random.key(seed)
    ks = jax.random.split(key, 32)
    D = D_MODEL
    return {
        'x': jax.random.normal(ks[0], (BATCH, SEQ, D), jnp.float32),
        'c': jax.random.normal(ks[1], (BATCH, D), jnp.float32),
        'ctx': jax.random.normal(ks[2], (BATCH, CTX_LEN, D), jnp.float32),
        'c_ctx': jax.random.normal(ks[3], (D,), jnp.float32),
        'norm_g': _gain(ks[4], (DEPTH, 3, D)),
        'w_mod': _dense(ks[5], (DEPTH, D, N_MOD * D), D, 0.5),
        'b_mod': 0.02 * jax.random.normal(ks[6], (DEPTH, N_MOD * D), jnp.float32),
        'ffn1_w13': _dense(ks[7], (DEPTH, D, 2 * D_FF), D),
        'ffn1_w2': _dense(ks[8], (DEPTH, D_FF, D), D_FF),
        'ffn2_w13': _dense(ks[9], (DEPTH, D, 2 * D_FF), D),
        'ffn2_w2': _dense(ks[10], (DEPTH, D_FF, D), D_FF),
        'a_w_in': _dense(ks[11], (N_A_LAYERS, D, A_Q_RANK + A_KV_RANK + A_ROPE), D),
        'a_q_norm': _gain(ks[12], (N_A_LAYERS, A_Q_RANK)),
        'a_kv_norm': _gain(ks[13], (N_A_LAYERS, A_KV_RANK)),
        'a_w_uq': _dense(ks[14], (N_A_LAYERS, A_Q_RANK, A_HEADS * (A_NOPE + A_ROPE)), A_Q_RANK),
        'a_w_ukv': _dense(ks[15], (N_A_LAYERS, A_KV_RANK, A_HEADS * (A_NOPE + A_V)), A_KV_RANK),
        'a_w_o': _dense(ks[16], (N_A_LAYERS, A_HEADS * A_V, D), A_HEADS * A_V),
        'b_w_qkv': _dense(ks[17], (N_B_LAYERS, D, (B_HEADS + 2 * B_KV_HEADS) * B_HEAD_DIM), D),
        'b_q_norm': _gain(ks[18], (N_B_LAYERS, B_HEAD_DIM)),
        'b_k_norm': _gain(ks[19], (N_B_LAYERS, B_HEAD_DIM)),
        'b_w_o': _dense(ks[20], (N_B_LAYERS, B_HEADS * B_HEAD_DIM, D), B_HEADS * B_HEAD_DIM),
        'c_w_qkv': _dense(ks[21], (N_C_LAYERS, D, 3 * C_HEADS * C_HEAD_DIM), D),
        'c_rpb': 0.1 * jax.random.normal(ks[22], (N_C_LAYERS, C_HEADS, 2 * C_WIN_ROWS - 1, 2 * C_WIN_COLS - 1), jnp.float32),
        'c_w_o': _dense(ks[23], (N_C_LAYERS, C_HEADS * C_HEAD_DIM, D), C_HEADS * C_HEAD_DIM),
        'final_norm_g': _gain(ks[24], (D,)),
    }


def reference(x, c, ctx, c_ctx, norm_g, w_mod, b_mod, ffn1_w13, ffn1_w2, ffn2_w13, ffn2_w2,
              a_w_in, a_q_norm, a_kv_norm, a_w_uq, a_w_ukv, a_w_o,
              b_w_qkv, b_q_norm, b_k_norm, b_w_o,
              c_w_qkv, c_rpb, c_w_o, final_norm_g):
    rows = x.shape[1] // GRID_W
    rope_a = axial_rope(rows, A_ROPE)
    rope_b = axial_rope(rows, B_HEAD_DIM)
    xc = ctx
    sc = jax.nn.silu(c)[:, None, :]
    scc = jax.nn.silu(c_ctx)
    for i in range(DEPTH):
        ctx_out = i < DEPTH - 1
        m = jnp.split(sc @ w_mod[i] + b_mod[i], N_MOD, axis=-1)
        mc = jnp.split(scc @ w_mod[i] + b_mod[i], N_MOD, axis=-1)
        x = half_ffn(x, norm_g[i, 0], m[0], m[1], m[2], ffn1_w13[i], ffn1_w2[i])
        xc = half_ffn(xc, norm_g[i, 0], mc[0], mc[1], mc[2], ffn1_w13[i], ffn1_w2[i])
        h = rmsnorm(x, norm_g[i, 1]) * (1 + m[4]) + m[3]
        hc = rmsnorm(xc, norm_g[i, 1]) * (1 + mc[4]) + mc[3]
        kind, j = i % N_MIXERS, i // N_MIXERS
        if kind == 0:
            o, oc = mixer_mla(h, hc, a_w_in[j], a_q_norm[j], a_kv_norm[j], a_w_uq[j], a_w_ukv[j], a_w_o[j], rope_a, ctx_out)
        elif kind == 1:
            o, oc = mixer_gqa(h, hc, b_w_qkv[j], b_q_norm[j], b_k_norm[j], b_w_o[j], rope_b, ctx_out)
        else:
            o, oc = mixer_neighbourhood(h, hc, c_w_qkv[j], c_rpb[j], c_w_o[j], ctx_out)
        x = x + m[5] * o
        x = half_ffn(x, norm_g[i, 2], m[6], m[7], m[8], ffn2_w13[i], ffn2_w2[i])
        if ctx_out:
            xc = xc + mc[5] * oc
            xc = half_ffn(xc, norm_g[i, 2], mc[6], mc[7], mc[8], ffn2_w13[i], ffn2_w2[i])
    return rmsnorm(x, final_norm_g)
```

```cpp
#include <hip/hip_runtime.h>
#include <hip/hip_bf16.h>
#include <hip/hip_cooperative_groups.h>
#include <cstdio>
#include <cstdint>
namespace cg = cooperative_groups;
namespace pg8 {
#define PG8_LAS __attribute__((address_space(3)))
typedef unsigned short bf16_t;
typedef short bf16x8 __attribute__((ext_vector_type(8)));
typedef float f32x4 __attribute__((ext_vector_type(4)));
typedef unsigned u32x4 __attribute__((ext_vector_type(4)));
constexpr int BM = 256, BK = 64, HALF = 128, HTB = HALF * BK * 2  , STAGE_BYTES = 8 * HTB, NXCD = 8, WGM = 8;

__host__ __device__ __forceinline__ int lds_byte(int r, int c) { const int st = (r >> 4) * 2 + (c >> 5), rr = r & 15, cc = c & 31, ob = rr * 64 + cc * 2; return st * 1024 + (ob ^ (((ob >> 9) & 1) << 5)); }
__host__ __device__ __forceinline__ void stage_rc(int b, int& R, int& C) { const int st = b / 1024, sb = b % 1024, swz = sb ^ (((sb >> 9) & 1) << 5); R = (st >> 1) * 16 + swz / 64; C = (st & 1) * 32 + (swz % 64) / 2; }
__host__ __device__ __forceinline__ int perm32(int rho) { const int n = rho >> 4, i = rho & 15; return 8 * (i >> 2) + 4 * n + (i & 3); }

struct Unit { int pm, pn; };
struct Gemm { const bf16_t* A; const bf16_t* Bt; int M, N, K; };

struct StaticOrder {
    int nM, nN, nwg, G, c;
    __host__ __device__ void init(int M, int N, int G_, int c_) { nM = M / BM; nN = N / BM; nwg = nM * nN; G = G_; c = c_; }
    __host__ __device__ bool next(int i, Unit& u) const {
        const long L = (long)i * G + c; if (L >= nwg) return false;
        int wgid = (int)L; { const int q = nwg / NXCD, r = nwg % NXCD, xcd = wgid % NXCD, off = wgid / NXCD; wgid = (xcd < r ? xcd * (q + 1) : r * (q + 1) + (xcd - r) * q) + off; }
        const int nig = WGM * nN, gid = wgid / nig, fm = gid * WGM, gsz = (nM - fm) < WGM ? (nM - fm) : WGM;
        u.pm = fm + ((wgid % nig) % gsz); u.pn = (wgid % nig) / gsz; return true;
    }
    __device__ __forceinline__ void a_ready(const Unit&) const {}
    __device__ __forceinline__ void done(const Unit&) const {}
};

__device__ __forceinline__ unsigned cvt_pk_bf16(float lo, float hi) { unsigned r; asm volatile("v_cvt_pk_bf16_f32 %0, %1, %2" : "=v"(r) : "v"(lo), "v"(hi)); return r; }
typedef float f32x2 __attribute__((ext_vector_type(2)));
__device__ __forceinline__ f32x2 gelu_pk(f32x2 v) {
    const f32x2 av = __builtin_elementwise_abs(v), d = av * 0.2316418882f + 1.0f;
    f32x2 t; t.x = __builtin_amdgcn_rcpf(d.x); t.y = __builtin_amdgcn_rcpf(d.y);
    f32x2 q = t * 0.5307027145f + (-0.7265760135f); q = q * t + 0.7107068705f; q = q * t + (-0.142248368f); q = q * t + 0.127414796f; q = q * t;
    const f32x2 s = (v * v) * (-0.72134752044f);
    f32x2 e; e.x = __builtin_amdgcn_exp2f(s.x); e.y = __builtin_amdgcn_exp2f(s.y);
    const f32x2 m = v * (q * e), r = v - m;
    f32x2 o; o.x = v.x < 0.f ? m.x : r.x; o.y = v.y < 0.f ? m.y : r.y; return o;
}

template <int ACT  > struct EpiBf16 {
    static constexpr bool PERM = true, AFTER_DRAIN = false; static_assert(ACT == 0 || ACT == 1, "EpiBf16: ACT is 0 (none) or 1 (gelu_pk)");
    bf16_t* O; int ldc; const float* bias; int split_cols; size_t split_stride; float scale0;
    __device__ __forceinline__ void operator()(const f32x4 (&acc)[2][2][4][2], const Unit& u, int wr, int wc, int fr, int fq) const {
        const int row0 = u.pm * BM + wr * 64 + fr; int colt = u.pn * BM; bf16_t* base = O;
        float sc = 1.f; if (split_cols) { const int t = colt / split_cols; base += (size_t)t * split_stride; colt -= t * split_cols; if (t == 0) sc = scale0; }
        const int col0 = colt + wc * 32 + 8 * fq, bcol0 = u.pn * BM + wc * 32 + 8 * fq;
        f32x4 bv[2][2];
#pragma unroll
        for (int bj = 0; bj < 2; ++bj)
#pragma unroll
            for (int n = 0; n < 2; ++n) bv[bj][n] = bias ? *(const f32x4*)(bias + bcol0 + bj * HALF + 4 * n) : (f32x4){0.f, 0.f, 0.f, 0.f};
#pragma unroll
        for (int ai = 0; ai < 2; ++ai)
#pragma unroll
            for (int m = 0; m < 4; ++m) { bf16_t* rowp = base + (size_t)(row0 + ai * HALF + m * 16) * ldc + col0;
#pragma unroll
                for (int bj = 0; bj < 2; ++bj) { f32x4 v0 = acc[ai][bj][m][0] + bv[bj][0], v1 = acc[ai][bj][m][1] + bv[bj][1];
                    if (ACT == 1) { f32x2 a = gelu_pk((f32x2){v0[0], v0[1]}), b = gelu_pk((f32x2){v0[2], v0[3]}), c = gelu_pk((f32x2){v1[0], v1[1]}), d = gelu_pk((f32x2){v1[2], v1[3]});
                        v0 = (f32x4){a.x, a.y, b.x, b.y}; v1 = (f32x4){c.x, c.y, d.x, d.y}; }
                    v0 = v0 * sc; v1 = v1 * sc; u32x4 w; w.x = cvt_pk_bf16(v0[0], v0[1]); w.y = cvt_pk_bf16(v0[2], v0[3]); w.z = cvt_pk_bf16(v1[0], v1[1]); w.w = cvt_pk_bf16(v1[2], v1[3]);
                    *(u32x4*)(rowp + bj * HALF) = w; } }
    }
};

__device__ __forceinline__ float silu_f(float g) { return g * __builtin_amdgcn_rcpf(1.0f + __builtin_amdgcn_exp2f(-1.4426950408889634f * g)); }
struct EpiSwiglu {
    static constexpr bool PERM = true, AFTER_DRAIN = false;
    bf16_t* O; int ldc;
    __device__ __forceinline__ void operator()(const f32x4 (&acc)[2][2][4][2], const Unit& u, int wr, int wc, int fr, int fq) const {
        const int row0 = u.pm * BM + wr * 64 + fr; const int col0 = u.pn * HALF + wc * 32 + 8 * fq;
#pragma unroll
        for (int ai = 0; ai < 2; ++ai)
#pragma unroll
            for (int m = 0; m < 4; ++m) { bf16_t* rowp = O + (size_t)(row0 + ai * HALF + m * 16) * ldc + col0;
                const f32x4 g0 = acc[ai][0][m][0], g1 = acc[ai][0][m][1], u0 = acc[ai][1][m][0], u1 = acc[ai][1][m][1];
                f32x4 v0, v1;
#pragma unroll
                for (int i = 0; i < 4; ++i) { v0[i] = silu_f(g0[i]) * u0[i]; v1[i] = silu_f(g1[i]) * u1[i]; }
                u32x4 w; w.x = cvt_pk_bf16(v0[0], v0[1]); w.y = cvt_pk_bf16(v0[2], v0[3]); w.z = cvt_pk_bf16(v1[0], v1[1]); w.w = cvt_pk_bf16(v1[2], v1[3]);
                *(u32x4*)rowp = w; }
    }
};
struct EpiRes {
    static constexpr bool PERM = false, AFTER_DRAIN = false;
    const float* srcL; const float* srcC; float* dstL; float* dstC; const float* gate; float f;
    __device__ __forceinline__ void operator()(const f32x4 (&acc)[2][2][4][2], const Unit& u, int wr, int wc, int fr, int fq) const {
        const int pm = u.pm; const int mb = pm < 128 ? (pm >> 4) : 8;
        const float* src = pm < 128 ? srcL + (size_t)pm * 256 * 1024 : srcC + (size_t)(pm - 128) * 256 * 1024;
        float* dst = pm < 128 ? dstL + (size_t)pm * 256 * 1024 : dstC + (size_t)(pm - 128) * 256 * 1024;
        const float* gp = gate + (size_t)mb * 9216;
        const int col0 = u.pn * BM + wc * 32 + 4 * fq;
        f32x4 gv[2][2];
#pragma unroll
        for (int bj = 0; bj < 2; ++bj)
#pragma unroll
            for (int n = 0; n < 2; ++n) gv[bj][n] = *(const f32x4*)(gp + col0 + bj * HALF + n * 16) * f;
#pragma unroll
        for (int ai = 0; ai < 2; ++ai)
#pragma unroll
            for (int m = 0; m < 4; ++m) { const int r = ai * HALF + wr * 64 + m * 16 + fr; const size_t off = (size_t)r * 1024 + col0;
#pragma unroll
                for (int bj = 0; bj < 2; ++bj)
#pragma unroll
                    for (int n = 0; n < 2; ++n) { const f32x4 b = *(const f32x4*)(src + off + bj * HALF + n * 16);
                        *(f32x4*)(dst + off + bj * HALF + n * 16) = b + gv[bj][n] * acc[ai][bj][m][n]; } }
    }
};
template <class Epi, class Sched, bool ALIGN_EPI = false, bool SP2 = false>
__device__ __forceinline__ void gemm_phase(PG8_LAS unsigned char* lds, const Gemm g, const Sched& S, const Epi& E) {
    int tid_ = threadIdx.x; asm volatile("" : "+v"(tid_)); const int tid = tid_, wid = __builtin_amdgcn_readfirstlane(tid >> 6), lane = tid & 63, wr = wid >> 2, wc = wid & 3, fr = lane & 15, fq = lane >> 4;
    const int K = g.K, nt = K / BK;
    unsigned voffA[2], voffB[2];
#pragma unroll
    for (int i = 0; i < 2; ++i) { int R, C; stage_rc(tid * 16 + i * 8192, R, C); const int Rb = Epi::PERM ? ((R & ~31) + perm32(R & 31)) : R;
        voffA[i] = (unsigned)(R * K + C) * 2u; voffB[i] = (unsigned)(Rb * K + C) * 2u; }
    const size_t kstep = (size_t)(BK * 2);
    const size_t hstep = (size_t)HALF * K * 2;
    const size_t tstep = 2 * hstep;
    const unsigned ldsw = (unsigned)wid * 1024u;
    const int aoff = lds_byte(wr * 64 + fr, fq * 8), boff = lds_byte(wc * 32 + fr, fq * 8);
#define PG8_SA(b, h) (((b) * 2 + (h)) * HTB)
#define PG8_SB(b, h) ((4 + (b) * 2 + (h)) * HTB)
#define PG8_STAGE(bufoff, gbase, voff) do { _Pragma("unroll") for (int _i = 0; _i < 2; ++_i) \
        __builtin_amdgcn_global_load_lds((const unsigned*)((const char*)(gbase) + (voff)[_i]), (PG8_LAS unsigned*)(lds + (bufoff) + ldsw + _i * 8192), 16, 0, 0); } while (0)
#define PG8_LDA(dst, b, h) do { _Pragma("unroll") for (int m = 0; m < 4; ++m) _Pragma("unroll") for (int k = 0; k < 2; ++k) dst[m][k] = *(const PG8_LAS bf16x8*)(lds + PG8_SA(b, h) + aoff + m * 2048 + k * 1024); } while (0)
#define PG8_LDB(dst, b, h) do { _Pragma("unroll") for (int n = 0; n < 2; ++n) _Pragma("unroll") for (int k = 0; k < 2; ++k) dst[n][k] = *(const PG8_LAS bf16x8*)(lds + PG8_SB(b, h) + boff + n * 2048 + k * 1024); } while (0)
#define PG8_MMA(ai, bj, At, Bt) do { __builtin_amdgcn_s_setprio(1); _Pragma("unroll") for (int m = 0; m < 4; ++m) _Pragma("unroll") for (int n = 0; n < 2; ++n) _Pragma("unroll") for (int k = 0; k < 2; ++k) \
        acc[ai][bj][m][n] = __builtin_amdgcn_mfma_f32_16x16x32_bf16(Bt[n][k], At[m][k], acc[ai][bj][m][n], 0, 0, 0); __builtin_amdgcn_s_setprio(0); } while (0)
#define PG8_WAIT_V(n) asm volatile("s_waitcnt vmcnt(" #n ")" ::: "memory")
#define PG8_WAIT_L(n) asm volatile("s_waitcnt lgkmcnt(" #n ")" ::: "memory")
#define PG8_BAR __builtin_amdgcn_s_barrier()
#define PG8_SCHED __builtin_amdgcn_sched_barrier(0)
    Unit cur, nxt; int ui = 0;
    if (!S.next(0, cur)) return;
    f32x4 acc[2][2][4][2];
#pragma unroll
    for (int a = 0; a < 2; ++a)
#pragma unroll
        for (int b = 0; b < 2; ++b)
#pragma unroll
            for (int m = 0; m < 4; ++m)
#pragma unroll
                for (int n = 0; n < 2; ++n) acc[a][b][m][n] = (f32x4){0.f, 0.f, 0.f, 0.f};
    bf16x8 At[4][2], B0[2][2], B1[2][2];
    const char* cA = (const char*)g.A + (size_t)cur.pm * tstep; const char* cB = (const char*)g.Bt + (size_t)cur.pn * tstep;
    S.a_ready(cur);
    if constexpr (SP2) {
        PG8_STAGE(PG8_SB(0, 0), cB, voffB); PG8_STAGE(PG8_SB(0, 1), cB + hstep, voffB); PG8_STAGE(PG8_SA(0, 0), cA, voffA); PG8_STAGE(PG8_SA(0, 1), cA + hstep, voffA);
        if (wr == 1) PG8_BAR;
        PG8_WAIT_V(2); PG8_BAR;
        PG8_STAGE(PG8_SB(1, 0), cB + kstep, voffB); PG8_STAGE(PG8_SA(1, 0), cA + kstep, voffA); PG8_STAGE(PG8_SB(1, 1), cB + hstep + kstep, voffB);
        PG8_WAIT_V(6); PG8_BAR;
    } else {
        PG8_STAGE(PG8_SB(0, 0), cB, voffB); PG8_STAGE(PG8_SA(0, 0), cA, voffA); PG8_STAGE(PG8_SB(0, 1), cB + hstep, voffB); PG8_STAGE(PG8_SA(0, 1), cA + hstep, voffA);
        if (wr == 1) PG8_BAR;
        PG8_WAIT_V(4); PG8_BAR;
        PG8_STAGE(PG8_SB(1, 0), cB + kstep, voffB); PG8_STAGE(PG8_SA(1, 0), cA + kstep, voffA); PG8_STAGE(PG8_SB(1, 1), cB + hstep + kstep, voffB);
        PG8_WAIT_V(6); PG8_BAR;
    }
    for (;;) {
        const bool has_next = S.next(ui + 1, nxt);
        const char* nA = has_next ? (const char*)g.A + (size_t)nxt.pm * tstep : cA; const char* nB = has_next ? (const char*)g.Bt + (size_t)nxt.pn * tstep : cB;
        for (int t = 0; t < nt; t += 2) {
            const bool last = (t == nt - 2);
            const char* a1 = cA + (size_t)(t + 1) * kstep;
            const char* a2 = last ? nA : cA + (size_t)(t + 2) * kstep; const char* b2 = last ? nB : cB + (size_t)(t + 2) * kstep;
            const char* a3 = a2 + kstep; const char* b3 = b2 + kstep;
            if (last && has_next) S.a_ready(nxt);
            if constexpr (SP2) {
            PG8_LDB(B0, 0, 0); PG8_LDB(B1, 0, 1); PG8_SCHED; PG8_LDA(At, 0, 0); PG8_STAGE(PG8_SA(1, 1), a1 + hstep, voffA);
            PG8_WAIT_V(8); PG8_WAIT_L(0); PG8_BAR; PG8_MMA(0, 0, At, B0); PG8_MMA(0, 1, At, B1); PG8_BAR; PG8_SCHED;
            PG8_LDA(At, 0, 1); PG8_STAGE(PG8_SB(0, 0), b2, voffB); PG8_STAGE(PG8_SB(0, 1), b2 + hstep, voffB); PG8_STAGE(PG8_SA(0, 0), a2, voffA);
            PG8_WAIT_V(8); PG8_WAIT_L(0); PG8_BAR; PG8_MMA(1, 0, At, B0); PG8_MMA(1, 1, At, B1); PG8_BAR; PG8_SCHED;
            PG8_LDB(B0, 1, 0); PG8_LDB(B1, 1, 1); PG8_SCHED; PG8_LDA(At, 1, 0); PG8_STAGE(PG8_SA(0, 1), a2 + hstep, voffA);
            PG8_WAIT_V(8); PG8_WAIT_L(0); PG8_BAR; PG8_MMA(0, 0, At, B0); PG8_MMA(0, 1, At, B1); PG8_BAR; PG8_SCHED;
            PG8_LDA(At, 1, 1); PG8_STAGE(PG8_SB(1, 0), b3, voffB); PG8_STAGE(PG8_SB(1, 1), b3 + hstep, voffB); PG8_STAGE(PG8_SA(1, 0), a3, voffA);
            PG8_WAIT_V(8); PG8_WAIT_L(0); PG8_BAR; PG8_MMA(1, 0, At, B0); PG8_MMA(1, 1, At, B1); PG8_BAR; PG8_SCHED;
            } else {
            PG8_LDB(B0, 0, 0); PG8_SCHED; PG8_LDA(At, 0, 0); PG8_STAGE(PG8_SA(1, 1), a1 + hstep, voffA);
            PG8_WAIT_L(8); PG8_BAR; PG8_WAIT_L(0); PG8_MMA(0, 0, At, B0); PG8_BAR; PG8_SCHED;
            PG8_LDB(B1, 0, 1); PG8_STAGE(PG8_SB(0, 0), b2, voffB);
            PG8_BAR; PG8_WAIT_L(0); PG8_MMA(0, 1, At, B1); PG8_BAR;
            PG8_LDA(At, 0, 1); PG8_STAGE(PG8_SA(0, 0), a2, voffA);
            PG8_BAR; PG8_WAIT_L(0); PG8_MMA(1, 0, At, B0); PG8_BAR; PG8_SCHED;
            PG8_STAGE(PG8_SB(0, 1), b2 + hstep, voffB);
            PG8_WAIT_V(6); PG8_BAR; PG8_MMA(1, 1, At, B1); PG8_BAR;
            PG8_LDB(B0, 1, 0); PG8_SCHED; PG8_LDA(At, 1, 0); PG8_STAGE(PG8_SA(0, 1), a2 + hstep, voffA);
            PG8_WAIT_L(8); PG8_BAR; PG8_WAIT_L(0); PG8_MMA(0, 0, At, B0); PG8_BAR; PG8_SCHED;
            PG8_LDB(B1, 1, 1); PG8_STAGE(PG8_SB(1, 0), b3, voffB);
            PG8_BAR; PG8_WAIT_L(0); PG8_MMA(0, 1, At, B1); PG8_BAR;
            PG8_LDA(At, 1, 1); PG8_STAGE(PG8_SA(1, 0), a3, voffA);
            PG8_BAR; PG8_WAIT_L(0); PG8_MMA(1, 0, At, B0); PG8_BAR; PG8_SCHED;
            PG8_STAGE(PG8_SB(1, 1), b3 + hstep, voffB);
            PG8_WAIT_V(6); PG8_BAR; PG8_MMA(1, 1, At, B1); PG8_BAR;
            }
        }
        if constexpr (ALIGN_EPI) { if (wr == 0) PG8_BAR; }
        if constexpr (!Epi::AFTER_DRAIN) { E(acc, cur, wr, wc, fr, fq); S.done(cur); }
        if (!has_next) break;
#pragma unroll
        for (int a = 0; a < 2; ++a)
#pragma unroll
            for (int b = 0; b < 2; ++b)
#pragma unroll
                for (int m = 0; m < 4; ++m)
#pragma unroll
                    for (int n = 0; n < 2; ++n) acc[a][b][m][n] = (f32x4){0.f, 0.f, 0.f, 0.f};
        cur = nxt; cA = nA; cB = nB; ++ui;
        if constexpr (ALIGN_EPI) { if (wr == 1) PG8_BAR; }
    }
    PG8_WAIT_V(0);
    if constexpr (!ALIGN_EPI) { if (wr == 0) PG8_BAR; }
    PG8_BAR;
    if constexpr (Epi::AFTER_DRAIN) { E.fused(acc, cur, wr, wc, fr, fq, lds, wid, lane); S.done(cur); }
#undef PG8_SA
#undef PG8_SB
#undef PG8_STAGE
#undef PG8_LDA
#undef PG8_LDB
#undef PG8_MMA
#undef PG8_WAIT_V
#undef PG8_WAIT_L
#undef PG8_BAR
#undef PG8_SCHED
}
}

namespace att {
typedef unsigned short bf16_t;
using bf16x8 = __attribute__((ext_vector_type(8))) short;
using s16x4  = __attribute__((ext_vector_type(4))) short;
using f32x16 = __attribute__((ext_vector_type(16))) float;
using u32x4  = __attribute__((ext_vector_type(4))) unsigned;
#define SBAR() __builtin_amdgcn_sched_barrier(0)
__device__ __forceinline__ int crow(int r, int hi) { return (r & 3) + 8 * (r >> 2) + 4 * hi; }
__device__ __forceinline__ unsigned cvtpk(float lo, float hi) { unsigned r; asm volatile("v_cvt_pk_bf16_f32 %0, %1, %2" : "=v"(r) : "v"(lo), "v"(hi)); return r; }
__device__ __forceinline__ bf16x8 ld8(const bf16_t* p) { return *reinterpret_cast<const bf16x8*>(p); }
__device__ __forceinline__ unsigned short f2bf1(float f) { unsigned u = __builtin_bit_cast(unsigned, f); return (unsigned short)((u + 0x7fffu + ((u >> 16) & 1u)) >> 16); }

struct AUnit {
  const bf16_t* q;
  const bf16_t* k1c; const bf16_t* k1l;
  const bf16_t* k2c; const bf16_t* k2l;
  const bf16_t* vc; const bf16_t* vl;
  bf16_t* o;
  int nt, nctx; float C;
  int R0, klo; const float* rpb;
};

__device__ __forceinline__ void partialSM(f32x16& p0, f32x16& p1, float& m_reg, float& mn, float& alpha, const float C, const float thr) {
  float pmax = p0[0];
#pragma unroll
  for (int r = 1; r < 16; ++r) pmax = fmaxf(pmax, p0[r]);
#pragma unroll
  for (int r = 0; r < 16; ++r) pmax = fmaxf(pmax, p1[r]);
  { auto rr = __builtin_amdgcn_permlane32_swap(__float_as_uint(pmax), __float_as_uint(pmax), false, false);
    pmax = fmaxf(__uint_as_float(rr[0]), __uint_as_float(rr[1])); }
  if (__builtin_expect(__all(pmax - m_reg <= thr), 1)) { mn = m_reg; alpha = 1.f; }
  else { mn = fmaxf(m_reg, pmax); alpha = __builtin_amdgcn_exp2f((m_reg - mn) * C); m_reg = mn; }
  float mnC = -mn * C;
#pragma unroll
  for (int r = 0; r < 16; ++r) p0[r] = fmaf(p0[r], C, mnC);
#pragma unroll
  for (int r = 0; r < 16; ++r) p1[r] = fmaf(p1[r], C, mnC);
#pragma unroll
  for (int r = 0; r < 16; ++r) p0[r] = __builtin_amdgcn_exp2f(p0[r]);
}
__device__ __forceinline__ void finishSM(f32x16& p0, f32x16& p1, float alpha, float& l_reg, bf16x8& pa0, bf16x8& pa1, bf16x8& pa2, bf16x8& pa3) {
#pragma unroll
  for (int r = 0; r < 16; ++r) p1[r] = __builtin_amdgcn_exp2f(p1[r]);
  float ps = 0;
#pragma unroll
  for (int r = 0; r < 16; ++r) ps += p0[r];
#pragma unroll
  for (int r = 0; r < 16; ++r) ps += p1[r];
  { auto rr = __builtin_amdgcn_permlane32_swap(__float_as_uint(ps), __float_as_uint(ps), false, false);
    ps = __uint_as_float(rr[0]) + __uint_as_float(rr[1]); }
  l_reg = l_reg * alpha + ps;
#define PK4(P, BASE, OUT) do { unsigned a0 = cvtpk(P[BASE + 0], P[BASE + 1]), a1 = cvtpk(P[BASE + 2], P[BASE + 3]);   \
    unsigned b0 = cvtpk(P[BASE + 4], P[BASE + 5]), b1 = cvtpk(P[BASE + 6], P[BASE + 7]);                              \
    auto r0 = __builtin_amdgcn_permlane32_swap(a0, b0, false, false); auto r1 = __builtin_amdgcn_permlane32_swap(a1, b1, false, false); \
    u32x4 w = {r0[0], r1[0], r0[1], r1[1]}; OUT = *reinterpret_cast<bf16x8*>(&w); } while (0)
  PK4(p0, 0, pa0); PK4(p0, 8, pa1); PK4(p1, 0, pa2); PK4(p1, 8, pa3);
#undef PK4
}
template <int DK> __device__ __forceinline__ int kswz(int row, int colB) { return row * (DK * 2) + (colB ^ ((row & 7) << 4)); }
template <int DK> __device__ __forceinline__ void qkt(f32x16& p0, f32x16& p1, const char* Ks, const bf16x8* qr, const char* qlds, int r32, int hi) {
  p0 = f32x16{}; p1 = f32x16{};
#pragma unroll
  for (int d0 = 0; d0 < DK / 16; ++d0) { int cb = (d0 * 16 + hi * 8) * 2;
    bf16x8 b0 = *reinterpret_cast<const bf16x8*>(Ks + kswz<DK>(r32, cb));
    bf16x8 b1 = *reinterpret_cast<const bf16x8*>(Ks + kswz<DK>(32 + r32, cb));
    bf16x8 qf;
    if (DK == 192 && d0 >= 8) qf = *reinterpret_cast<const bf16x8*>(qlds + (d0 - 8) * 1024); else qf = qr[d0 < 8 ? d0 : 0];
    p0 = __builtin_amdgcn_mfma_f32_32x32x16_bf16(b0, qf, p0, 0, 0, 0);
    p1 = __builtin_amdgcn_mfma_f32_32x32x16_bf16(b1, qf, p1, 0, 0, 0); }
}
template <int DV> __device__ __forceinline__ int v_st(int k, int c) { const int kk = (k & ~0xC) | ((k & 4) << 1) | ((k & 8) >> 1); return ((kk >> 3) * (DV / 32) + (c >> 5)) * 512 + ((kk & 7) * 32 + (c & 31)) * 2; }
__device__ __forceinline__ int v_rd_base(int lane) { return ((lane & 3) << 3) | (((lane >> 2) & 3) << 6) | (((lane >> 4) & 1) << 5) | (((lane >> 5) & 1) << 8); }
template <int DV> constexpr int v_rd_off(int d0, int ks, int half) { return d0 * 512 + ks * (2 * (DV / 32) * 512) + half * ((DV / 32) * 512); }
template <int OFF> __device__ __forceinline__ s16x4 tr_read(int vb) {
  s16x4 r; asm volatile("ds_read_b64_tr_b16 %0, %1 offset:%2" : "=&v"(r) : "v"(vb), "i"(OFF) : "memory"); return r;
}
template <int D0, int DV> __device__ __forceinline__ void pv_one(f32x16& od, int vb, bf16x8 pa0, bf16x8 pa1, bf16x8 pa2, bf16x8 pa3) {
  const s16x4 l0 = tr_read<v_rd_off<DV>(D0, 0, 0)>(vb), h0 = tr_read<v_rd_off<DV>(D0, 0, 1)>(vb), l1 = tr_read<v_rd_off<DV>(D0, 1, 0)>(vb), h1 = tr_read<v_rd_off<DV>(D0, 1, 1)>(vb);
  const s16x4 l2 = tr_read<v_rd_off<DV>(D0, 2, 0)>(vb), h2 = tr_read<v_rd_off<DV>(D0, 2, 1)>(vb), l3 = tr_read<v_rd_off<DV>(D0, 3, 0)>(vb), h3 = tr_read<v_rd_off<DV>(D0, 3, 1)>(vb);
  asm volatile("s_waitcnt lgkmcnt(0)" ::: "memory"); SBAR();
#define PK(L, H) (bf16x8){L[0], L[1], L[2], L[3], H[0], H[1], H[2], H[3]}
  od = __builtin_amdgcn_mfma_f32_32x32x16_bf16(pa0, PK(l0, h0), od, 0, 0, 0);
  od = __builtin_amdgcn_mfma_f32_32x32x16_bf16(pa1, PK(l1, h1), od, 0, 0, 0);
  od = __builtin_amdgcn_mfma_f32_32x32x16_bf16(pa2, PK(l2, h2), od, 0, 0, 0);
  od = __builtin_amdgcn_mfma_f32_32x32x16_bf16(pa3, PK(l3, h3), od, 0, 0, 0);
#undef PK
}
template <int DV> __device__ __forceinline__ void pv_all(f32x16* o, int vb, bf16x8 pa0, bf16x8 pa1, bf16x8 pa2, bf16x8 pa3) {
  pv_one<0, DV>(o[0], vb, pa0, pa1, pa2, pa3); pv_one<1, DV>(o[1], vb, pa0, pa1, pa2, pa3);
  if constexpr (DV == 128) { pv_one<2, DV>(o[2], vb, pa0, pa1, pa2, pa3); pv_one<3, DV>(o[3], vb, pa0, pa1, pa2, pa3); }
}
__device__ __forceinline__ void nb_mask(f32x16& p0, f32x16& p1, bool rowok, int tbase, int cs, int hi, const float* T) {
#pragma unroll
  for (int r = 0; r < 16; ++r) { const int kc = crow(r, hi);
    const bool in0 = rowok && kc >= cs && kc < cs + 16; const float b0 = T[tbase + kc]; p0[r] = in0 ? p0[r] + b0 : -1e30f;
    const int kc1 = kc + 32;
    const bool in1 = rowok && kc1 >= cs && kc1 < cs + 16; const float b1 = T[tbase + kc1]; p1[r] = in1 ? p1[r] + b1 : -1e30f; }
}

template <int DK, int DV> constexpr int attn_lds_bytes() { return 2 * 64 * DV * 2 + 2 * 64 * DK * 2 + 2048 + 15 * 128 * 4; }

template <int DK, int DV, int MODE, int SD, int LDQ, int LDK1, int LDK2, int LDV, int LDO>
__device__ __forceinline__ void attn_unit(const AUnit& u, char* lds) {
  constexpr int KBYT = 64 * DK * 2, VBYT = 64 * DV * 2, ND = DK / 16, NO = DV / 32;
  constexpr int OFF_WS = 2 * VBYT + 2 * KBYT, OFF_T = OFF_WS + 2048, OFF_Q = OFF_T + 15 * 128 * 4, NDR = ND > 8 ? 8 : ND;
  constexpr int NLD = (DK == 192 ? 3 : (DK == 128 ? 2 : 1)) + (DV == 128 ? 2 : 1);
  int tid_ = threadIdx.x; asm volatile("" : "+v"(tid_)); const int tid = tid_, wid = __builtin_amdgcn_readfirstlane(tid >> 6), lane = tid & 63, r32 = lane & 31, hi = lane >> 5;
  char* V_lds = lds; char* K_lds = lds + 2 * VBYT;
  float* wsf = (float*)(lds + OFF_WS) + wid * 64; float* li_l = wsf; float* al_l = wsf + 32;
  float* T = (float*)(lds + OFF_T);
  __syncthreads();
  int qrow = 0, qcol = 0, r0w = 0, cs = 0;
  if constexpr (MODE == 1) {
    if (u.nt > u.nctx) { for (int e = tid; e < 15 * 128; e += 512) { const int ro = e >> 7, d = (e & 127) - 64; T[e] = (d >= -15 && d <= 15) ? 8.0f * u.rpb[ro * 31 + d + 15] : 0.f; } }
    qrow = u.R0 + (wid >> 1); qcol = (wid & 1) * 32 + r32;
    r0w = qrow - 4; r0w = r0w < 0 ? 0 : (r0w > 56 ? 56 : r0w);
    cs = qcol - 8; cs = cs < 0 ? 0 : (cs > 48 ? 48 : cs);
  }
  const float C = u.C, thr = 8.0f * 1.4426950408889634f / C;
  float m_reg = -1e30f, l_reg = 0; f32x16 o[NO] = {}; bf16x8 qr[NDR];
  char* qlds = lds + OFF_Q + wid * 4096 + lane * 16;
  const bf16_t* Qw = u.q + (unsigned)((wid * 32 + r32) * LDQ + hi * 8);
#pragma unroll
  for (int d0 = 0; d0 < NDR; ++d0) qr[d0] = ld8(Qw + d0 * 16);
  if constexpr (DK == 192) {
#pragma unroll
    for (int d0 = 0; d0 < 4; ++d0) *reinterpret_cast<bf16x8*>(qlds + d0 * 1024) = ld8(Qw + (8 + d0) * 16); }
  const int sr = tid >> 4, sc = (tid & 15) * 8, sr6 = tid >> 3, sc6 = (tid & 7) * 8;
  const unsigned kof = (DK >= 128 ? (unsigned)(sr * LDK1 + sc) : (unsigned)(sr6 * LDK1 + sc6)) * 2u, k2of = (unsigned)(sr6 * LDK2 + sc6) * 2u, vof = (DV == 128 ? (unsigned)(sr * LDV + sc) : (unsigned)(sr6 * LDV + sc6)) * 2u;
  const int vb0 = (int)(uintptr_t)V_lds + v_rd_base(lane);
  struct { bf16x8 k0, k1, k2, v0, v1; } st[SD];
#define TILEP(bc, bl, ld, j) ((const char*)((j) < u.nctx ? (bc) + (long)(j) * 64 * (ld) : (bl) + (long)((j) - u.nctx) * 64 * (ld)))
#define LDB(base, off) (*reinterpret_cast<const bf16x8*>((base) + (off)))
#define SLOAD(i, j) do { const char* kp_ = TILEP(u.k1c, u.k1l, LDK1, j); const char* vp_ = TILEP(u.vc, u.vl, LDV, j); \
    if constexpr (DK >= 128) { st[i].k0 = LDB(kp_, kof); st[i].k1 = LDB(kp_ + 32 * LDK1 * 2, kof); } \
    if constexpr (DK == 192) { const char* k2_ = TILEP(u.k2c, u.k2l, LDK2, j); st[i].k2 = LDB(k2_, k2of); } \
    if constexpr (DK == 64) { st[i].k0 = LDB(kp_, kof); } \
    if constexpr (DV == 128) { st[i].v0 = LDB(vp_, vof); st[i].v1 = LDB(vp_ + 32 * LDV * 2, vof); } \
    else { st[i].v0 = LDB(vp_, vof); } } while (0)
#define SWRITE(b, i) do { \
    if constexpr (DV == 128) { *(bf16x8*)(V_lds + (b) * VBYT + v_st<DV>(sr, sc)) = st[i].v0; *(bf16x8*)(V_lds + (b) * VBYT + v_st<DV>(32 + sr, sc)) = st[i].v1; } \
    else { *(bf16x8*)(V_lds + (b) * VBYT + v_st<DV>(sr6, sc6)) = st[i].v0; } \
    if constexpr (DK >= 128) { *(bf16x8*)(K_lds + (b) * KBYT + kswz<DK>(sr, sc * 2)) = st[i].k0; *(bf16x8*)(K_lds + (b) * KBYT + kswz<DK>(32 + sr, sc * 2)) = st[i].k1; } \
    if constexpr (DK == 192) { *(bf16x8*)(K_lds + (b) * KBYT + kswz<DK>(sr6, 256 + sc6 * 2)) = st[i].k2; } \
    if constexpr (DK == 64) { *(bf16x8*)(K_lds + (b) * KBYT + kswz<DK>(sr6, sc6 * 2)) = st[i].k0; } } while (0)
#define SWAIT() do { if constexpr (SD == 2 && NLD == 4) asm volatile("s_waitcnt vmcnt(4)" ::: "memory"); else if constexpr (SD == 2 && NLD == 2) asm volatile("s_waitcnt vmcnt(2)" ::: "memory"); \
    else asm volatile("s_waitcnt vmcnt(0)" ::: "memory"); } while (0)
#define RESC(a) do { if (__any((a) < 1.f)) { if (hi == 0) al_l[r32] = (a); asm volatile("s_waitcnt lgkmcnt(0)" ::: "memory"); \
    _Pragma("unroll") for (int d = 0; d < NO; ++d) _Pragma("unroll") for (int r = 0; r < 16; ++r) o[d][r] *= al_l[crow(r, hi)]; } } while (0)
#define MASK(P0, P1, j) do { if constexpr (MODE == 1) { if ((j) >= u.nctx) { const int krow_ = u.klo + (j) - u.nctx; const bool rowok_ = krow_ >= r0w && krow_ < r0w + 8; \
    int dr_ = krow_ - qrow + 7; dr_ = dr_ < 0 ? 0 : (dr_ > 14 ? 14 : dr_); nb_mask(P0, P1, rowok_, dr_ * 128 + 64 - qcol, cs, hi, T); } } } while (0)
  f32x16 pA0, pA1, pB0, pB1; float mnA, mnB, alA, alB; bf16x8 pa0, pa1, pa2, pa3; const int NT = u.nt;
  constexpr int SE = 0, SO = SD - 1;
  SLOAD(SE, 0); asm volatile("s_waitcnt vmcnt(0)" ::: "memory"); SWRITE(0, SE); __syncthreads();
  qkt<DK>(pA0, pA1, K_lds, qr, qlds, r32, hi); MASK(pA0, pA1, 0); partialSM(pA0, pA1, m_reg, mnA, alA, C, thr);
  SLOAD(SO, 1); if constexpr (SD == 2) { if (2 < NT) SLOAD(SE, 2); }
  SWAIT(); SWRITE(1, SO); __syncthreads();
  for (int j = 1; j + 1 < NT; j += 2) {
    SBAR(); qkt<DK>(pB0, pB1, K_lds + KBYT, qr, qlds, r32, hi); MASK(pB0, pB1, j);
    finishSM(pA0, pA1, alA, l_reg, pa0, pa1, pa2, pa3); SBAR();
    SLOAD(SO, j + SD); SBAR();
    pv_all<DV>(o, vb0, pa0, pa1, pa2, pa3); partialSM(pB0, pB1, m_reg, mnB, alB, C, thr);
    __syncthreads(); SWAIT(); SWRITE(0, SE);
    RESC(alB); __syncthreads();
    SBAR(); qkt<DK>(pA0, pA1, K_lds, qr, qlds, r32, hi); MASK(pA0, pA1, j + 1);
    finishSM(pB0, pB1, alB, l_reg, pa0, pa1, pa2, pa3); SBAR();
    if (SD == 1 || j + 3 < NT) SLOAD(SE, j + 1 + SD); SBAR();
    pv_all<DV>(o, vb0 + VBYT, pa0, pa1, pa2, pa3); partialSM(pA0, pA1, m_reg, mnA, alA, C, thr);
    __syncthreads(); SWAIT(); SWRITE(1, SO);
    RESC(alA); __syncthreads();
  }
  SBAR(); qkt<DK>(pB0, pB1, K_lds + KBYT, qr, qlds, r32, hi); MASK(pB0, pB1, NT - 1);
  finishSM(pA0, pA1, alA, l_reg, pa0, pa1, pa2, pa3); SBAR();
  pv_all<DV>(o, vb0, pa0, pa1, pa2, pa3); partialSM(pB0, pB1, m_reg, mnB, alB, C, thr);
  __syncthreads(); RESC(alB);
  finishSM(pB0, pB1, alB, l_reg, pa0, pa1, pa2, pa3); SBAR();
  pv_all<DV>(o, vb0 + VBYT, pa0, pa1, pa2, pa3);
  if (hi == 0) li_l[r32] = l_reg; asm volatile("s_waitcnt lgkmcnt(0)" ::: "memory");
  float rli[16];
#pragma unroll
  for (int r = 0; r < 16; ++r) rli[r] = __builtin_amdgcn_rcpf(li_l[crow(r, hi)]);
  bf16_t* Ow = u.o + (long)(wid * 32) * LDO;
#pragma unroll
  for (int r = 0; r < 16; ++r) { const int orow = crow(r, hi);
#pragma unroll
    for (int d0 = 0; d0 < NO; ++d0) Ow[orow * LDO + d0 * 32 + r32] = f2bf1(o[d0][r] * rli[r]); }
#undef TILEP
#undef LDB
#undef SLOAD
#undef SWRITE
#undef SWAIT
#undef RESC
#undef MASK
}
#undef SBAR
}
#ifndef EN
#define EN 127
#endif
#ifndef AEN
#define AEN 7
#endif

#define LAS __attribute__((address_space(3)))
typedef unsigned short bf16_t;
typedef float f32x4 __attribute__((ext_vector_type(4)));
typedef unsigned u32x4v __attribute__((ext_vector_type(4)));
typedef unsigned u32x2v __attribute__((ext_vector_type(2)));

constexpr int DM = 1024, NB = 8, SEQ = 4096, ML = NB * SEQ, CTXL = 256, MC = NB * CTXL, MT = ML + MC, DFF = 2816, DEPTH = 4;
constexpr float EPS = 1e-6f;
constexpr float LOG2_THETA = 13.287712379549449f;
constexpr size_t MiB = 1u << 20;
constexpr size_t WS_MOD = 1 * MiB, WS_XC = 4 * MiB, WS_W = 12 * MiB, WS_XN = 172 * MiB, WS_TMP = 240 * MiB, WS_END = 530 * MiB;
constexpr size_t W_LAYER = 17301504, W_13A = 0, W_2A = 5767168, W_13B = 8650752, W_2B = 14417920;
constexpr size_t W_MX = 69206016, W_ASZ = 2949120, W_A_IN = 0, W_A_UQ = 786432, W_A_UKV = 1376256, W_A_O = 1900544;
constexpr size_t W_MXB = W_MX + 2 * W_ASZ, W_B_QKV = 0, W_B_O = 1572864;
constexpr size_t W_MXC = W_MXB + 2621440, W_C_QKV = 0, W_C_O = 3145728;
static_assert(W_MXC + 4194304 == 81920000 && WS_W + 81920000ull * 2 <= WS_XN, "weight map");
constexpr size_t T_ACT = 0;
constexpr size_t T_AQ = 0, T_ACQN = 102 * MiB, T_ACKVN = 128 * MiB, T_AKR = 146 * MiB, T_AKV = 152 * MiB, T_APROJ = 152 * MiB;
constexpr size_t T_PROJ = 0;
static_assert(WS_TMP + T_AKV + (size_t)MT * 2048 * 2 <= WS_END && WS_TMP + (size_t)MT * 3072 * 2 <= WS_END, "tmp map");
constexpr int LDS_BYTES = 147456;

struct KP { const float* in[25]; float* out; unsigned char* ws; };

__device__ __forceinline__ unsigned f2bf(float f) { unsigned u = __builtin_bit_cast(unsigned, f); return (u + 0x7fffu + ((u >> 16) & 1u)) >> 16; }
__device__ __forceinline__ unsigned pk2(float lo, float hi) { return f2bf(lo) | (f2bf(hi) << 16); }
__device__ __forceinline__ float bf2f(unsigned short b) { return __builtin_bit_cast(float, (unsigned)b << 16); }
__device__ __forceinline__ float bflo(unsigned w) { return __builtin_bit_cast(float, w << 16); }
__device__ __forceinline__ float bfhi(unsigned w) { return __builtin_bit_cast(float, w & 0xffff0000u); }
__device__ __forceinline__ float wave_sum(float v) {
#pragma unroll
    for (int o = 1; o < 64; o <<= 1) v += __shfl_xor(v, o);
    return v;
}
#define LDS_WAIT() asm volatile("s_waitcnt lgkmcnt(0)" ::: "memory")

__device__ __forceinline__ void transpose_item(const float* W, int K, int N, bf16_t* WT, int mode, LAS float* scr, int item, int lane) {
    const int nblk = N / 32, kb = item / nblk, nb = item % nblk, k0 = 64 * kb, n0 = 32 * nb;
    int drow0 = n0;
    if (mode == 1) drow0 = n0 < DFF ? ((n0 >> 7) * 256 + (n0 & 127)) : (((n0 - DFF) >> 7) * 256 + 128 + ((n0 - DFF) & 127));
#pragma unroll 8
    for (int i = 0; i < 32; ++i) { const int kk = 2 * i + (lane >> 5); scr[kk * 33 + (lane & 31)] = W[(size_t)(k0 + kk) * N + n0 + (lane & 31)]; }
    LDS_WAIT(); asm volatile("" ::: "memory");
    const int c = lane & 7;
#pragma unroll
    for (int j = 0; j < 4; ++j) { const int n = (lane >> 3) + 8 * j; const LAS float* s = scr + (8 * c) * 33 + n;
        u32x4v o; o.x = pk2(s[0 * 33], s[1 * 33]); o.y = pk2(s[2 * 33], s[3 * 33]); o.z = pk2(s[4 * 33], s[5 * 33]); o.w = pk2(s[6 * 33], s[7 * 33]);
        *(u32x4v*)(WT + (size_t)(drow0 + n) * K + k0 + 8 * c) = o; }
    LDS_WAIT(); asm volatile("" ::: "memory");
}
__device__ __forceinline__ void cvt_job(const KP& p, bf16_t* Wb, int job, const float*& src, int& K, int& N, bf16_t*& dst, int& mode) {
    mode = 0;
    if (job < 16) { const int l = job >> 2, t = job & 3; bf16_t* lb = Wb + (size_t)l * W_LAYER;
        if (t == 0)      { src = p.in[7]  + (size_t)l * 1024 * 5632; K = 1024; N = 5632; dst = lb + W_13A; mode = 1; }
        else if (t == 1) { src = p.in[8]  + (size_t)l * 2816 * 1024; K = 2816; N = 1024; dst = lb + W_2A; }
        else if (t == 2) { src = p.in[9]  + (size_t)l * 1024 * 5632; K = 1024; N = 5632; dst = lb + W_13B; mode = 1; }
        else             { src = p.in[10] + (size_t)l * 2816 * 1024; K = 2816; N = 1024; dst = lb + W_2B; }
    } else if (job < 24) { const int a = job - 16, j = a >> 2, t = a & 3; bf16_t* mb = Wb + W_MX + (size_t)j * W_ASZ;
        if (t == 0)      { src = p.in[11] + (size_t)j * 1024 * 704;  K = 1024; N = 704;  dst = mb + W_A_IN; }
        else if (t == 1) { src = p.in[14] + (size_t)j * 384 * 1536;  K = 384;  N = 1536; dst = mb + W_A_UQ; }
        else if (t == 2) { src = p.in[15] + (size_t)j * 256 * 2048;  K = 256;  N = 2048; dst = mb + W_A_UKV; }
        else             { src = p.in[16] + (size_t)j * 1024 * 1024; K = 1024; N = 1024; dst = mb + W_A_O; }
    } else if (job == 24) { src = p.in[17]; K = 1024; N = 1536; dst = Wb + W_MXB + W_B_QKV; }
    else if (job == 25)   { src = p.in[20]; K = 1024; N = 1024; dst = Wb + W_MXB + W_B_O; }
    else if (job == 26)   { src = p.in[21]; K = 1024; N = 3072; dst = Wb + W_MXC + W_C_QKV; }
    else                  { src = p.in[23]; K = 1024; N = 1024; dst = Wb + W_MXC + W_C_O; }
}
__device__ __forceinline__ void prologue_phase(const KP& p, LAS unsigned char* lds, int tid, int lane, int wave, int G) {
    bf16_t* Wb = (bf16_t*)(p.ws + WS_W);
    {
        LAS float* sv = (LAS float*)lds;
        LAS float* red = (LAS float*)(lds + 40960);
        const float* c = p.in[1]; const float* cc = p.in[3];
        for (int e = tid; e < 9 * 1024; e += 512) { const float x = e < 8192 ? c[e] : cc[e - 8192]; sv[e] = x / (1.0f + __expf(-x)); }
        __syncthreads();
        float* MOD = (float*)(p.ws + WS_MOD);
        const int cg4 = tid & 31, ks = tid >> 5;
        for (int item = blockIdx.x; item < 288; item += G) {
            const int colg = item * 128, l = colg / 9216, n0 = colg % 9216;
            const float* wp = p.in[5] + ((size_t)l * 1024 + ks * 64) * 9216 + n0 + cg4 * 4;
            f32x4 acc[9];
#pragma unroll
            for (int j = 0; j < 9; ++j) acc[j] = (f32x4){0.f, 0.f, 0.f, 0.f};
#pragma unroll 4
            for (int k = 0; k < 64; ++k) { const f32x4 w = *(const f32x4*)(wp + (size_t)k * 9216);
#pragma unroll
                for (int j = 0; j < 9; ++j) acc[j] += w * sv[j * 1024 + ks * 64 + k]; }
#pragma unroll
            for (int j = 0; j < 9; ++j) *(LAS f32x4*)(red + (ks * 9 + j) * 128 + cg4 * 4) = acc[j];
            __syncthreads();
            for (int e = tid; e < 9 * 128; e += 512) { const int j = e >> 7, cidx = e & 127; float s = p.in[6][(size_t)l * 9216 + n0 + cidx];
#pragma unroll
                for (int q = 0; q < 16; ++q) s += red[(q * 9 + j) * 128 + cidx];
                MOD[((size_t)l * 9 + j) * 9216 + n0 + cidx] = s; }
            __syncthreads();
        }
    }
    __syncthreads();
    {
        LAS float* scr = (LAS float*)(lds + wave * 16384);
        const int gw = blockIdx.x * 8 + wave, NGW = G * 8;
        int base = 0;
        for (int job = 0; job < 28; ++job) {
            const float* src; int K, N, mode; bf16_t* dst;
            cvt_job(p, Wb, job, src, K, N, dst, mode);
            const int nitems = (K / 64) * (N / 32);
            int first = gw - base; if (first < 0) first += NGW;
            for (int it = first; it < nitems; it += NGW) transpose_item(src, K, N, dst, mode, scr, it, lane);
            base = (base + nitems) % NGW;
        }
        for (int e = blockIdx.x * 512 + tid; e < 2 * 64 * 1024 / 8; e += G * 512) { const int j = e / 8192, r = e % 8192;
            *(u32x4v*)(Wb + W_MX + (size_t)j * W_ASZ + W_A_IN + (size_t)704 * 1024 + (size_t)r * 8) = (u32x4v){0u, 0u, 0u, 0u}; }
    }
}

__device__ __forceinline__ void norm_phase(const float* xL, const float* xC, const float* g, const float* shift, const float* scale, bf16_t* XN, int gw, int NGW, int lane) {
    for (int row = gw; row < MT; row += NGW) {
        const int mb = row < ML ? (row >> 12) : 8;
        const float* xr = row < ML ? xL + (size_t)row * DM : xC + (size_t)(row - ML) * DM;
        f32x4 v[4]; float ss = 0.f;
#pragma unroll
        for (int j = 0; j < 4; ++j) { v[j] = *(const f32x4*)(xr + (lane + 64 * j) * 4); ss += (v[j].x * v[j].x + v[j].y * v[j].y) + (v[j].z * v[j].z + v[j].w * v[j].w); }
        const float rstd = __builtin_amdgcn_rsqf(wave_sum(ss) * (1.0f / DM) + EPS);
        const float* sh = shift + (size_t)mb * 9216; const float* sc = scale + (size_t)mb * 9216;
#pragma unroll
        for (int j = 0; j < 4; ++j) { const int col = (lane + 64 * j) * 4;
            const f32x4 gg = *(const f32x4*)(g + col), s1 = *(const f32x4*)(sc + col), s0 = *(const f32x4*)(sh + col);
            const f32x4 y = (v[j] * rstd) * gg * (s1 + 1.0f) + s0;
            u32x2v w; w.x = pk2(y.x, y.y); w.y = pk2(y.z, y.w);
            *(u32x2v*)(XN + (size_t)row * DM + col) = w; }
    }
}
__device__ __forceinline__ void final_norm_phase(float* x, const float* g, int gw, int NGW, int lane) {
    for (int row = gw; row < ML; row += NGW) {
        float* xr = x + (size_t)row * DM;
        f32x4 v[4]; float ss = 0.f;
#pragma unroll
        for (int j = 0; j < 4; ++j) { v[j] = *(const f32x4*)(xr + (lane + 64 * j) * 4); ss += (v[j].x * v[j].x + v[j].y * v[j].y) + (v[j].z * v[j].z + v[j].w * v[j].w); }
        const float rstd = __builtin_amdgcn_rsqf(wave_sum(ss) * (1.0f / DM) + EPS);
#pragma unroll
        for (int j = 0; j < 4; ++j) { const int col = (lane + 64 * j) * 4; const f32x4 gg = *(const f32x4*)(g + col);
            *(f32x4*)(xr + col) = (v[j] * rstd) * gg; }
    }
}
__device__ __forceinline__ void mla_norm_phase(const bf16_t* PROJ, const float* gq, const float* gkv, bf16_t* CQN, bf16_t* CKVN, bf16_t* KR, int gw, int NGW, int lane) {
    const int pidx = lane & 31;
    const float invf = __builtin_amdgcn_exp2f(-(float)(pidx & 15) * (LOG2_THETA / 16.0f));
    for (int row = gw; row < MT; row += NGW) {
        const bf16_t* pr = PROJ + (size_t)row * 768;
        unsigned q[3]; float ss = 0.f;
#pragma unroll
        for (int i = 0; i < 3; ++i) { q[i] = *(const unsigned*)(pr + lane * 2 + 128 * i); const float a = bflo(q[i]), b = bfhi(q[i]); ss += a * a + b * b; }
        const u32x2v kv = *(const u32x2v*)(pr + 384 + lane * 4);
        const float k0 = bflo(kv.x), k1 = bfhi(kv.x), k2 = bflo(kv.y), k3 = bfhi(kv.y);
        float s2 = (k0 * k0 + k1 * k1) + (k2 * k2 + k3 * k3);
        const float xr = bf2f(pr[640 + lane]);
        const float rq = __builtin_amdgcn_rsqf(wave_sum(ss) * (1.0f / 384.0f) + EPS);
        const float rkv = __builtin_amdgcn_rsqf(wave_sum(s2) * (1.0f / 256.0f) + EPS);
#pragma unroll
        for (int i = 0; i < 3; ++i) { const int col = lane * 2 + 128 * i;
            *(unsigned*)(CQN + (size_t)row * 384 + col) = pk2(bflo(q[i]) * rq * gq[col], bfhi(q[i]) * rq * gq[col + 1]); }
        { const int col = lane * 4; const f32x4 gg = *(const f32x4*)(gkv + col);
          u32x2v w; w.x = pk2(k0 * rkv * gg.x, k1 * rkv * gg.y); w.y = pk2(k2 * rkv * gg.z, k3 * rkv * gg.w);
          *(u32x2v*)(CKVN + (size_t)row * 256 + col) = w; }
        float outv = xr;
        const float other = __shfl_xor(xr, 32);
        if (row < ML) { const int t = row & 4095; const float pos = (float)(pidx < 16 ? (t >> 6) : (t & 63)); const float ang = pos * invf;
            const float cs = __cosf(ang), sn = __sinf(ang);
            outv = lane < 32 ? (xr * cs - other * sn) : (xr * cs + other * sn); }
        KR[(size_t)row * 64 + lane] = (bf16_t)f2bf(outv);
    }
}
__device__ __forceinline__ void mla_qrope_phase(bf16_t* Q, int gw, int NGW, int lane) {
    const int head = lane >> 3, sub = lane & 7;
    float invf[4];
#pragma unroll
    for (int i = 0; i < 4; ++i) invf[i] = __builtin_amdgcn_exp2f(-(float)((sub * 4 + i) & 15) * (LOG2_THETA / 16.0f));
    for (int row = gw; row < ML; row += NGW) {
        bf16_t* qp = Q + (size_t)row * 1536 + head * 192 + 128 + sub * 4;
        const u32x2v a = *(const u32x2v*)qp, b = *(const u32x2v*)(qp + 32);
        const float x1[4] = {bflo(a.x), bfhi(a.x), bflo(a.y), bfhi(a.y)}, x2[4] = {bflo(b.x), bfhi(b.x), bflo(b.y), bfhi(b.y)};
        const int t = row & 4095; const float pos = (float)(sub < 4 ? (t >> 6) : (t & 63));
        float o1[4], o2[4];
#pragma unroll
        for (int i = 0; i < 4; ++i) { const float ang = pos * invf[i]; const float cs = __cosf(ang), sn = __sinf(ang);
            o1[i] = x1[i] * cs - x2[i] * sn; o2[i] = x2[i] * cs + x1[i] * sn; }
        u32x2v w1, w2; w1.x = pk2(o1[0], o1[1]); w1.y = pk2(o1[2], o1[3]); w2.x = pk2(o2[0], o2[1]); w2.y = pk2(o2[2], o2[3]);
        *(u32x2v*)qp = w1; *(u32x2v*)(qp + 32) = w2;
    }
}
__device__ __forceinline__ void gqa_normrope_phase(bf16_t* PROJ, const float* gq, const float* gk, int gw, int NGW, int lane) {
    const float invf = __builtin_amdgcn_exp2f(-(float)(lane & 31) * (LOG2_THETA / 32.0f));
    for (int row = gw; row < MT; row += NGW) {
        bf16_t* pr = PROJ + (size_t)row * 1536;
        const bool lat = row < ML; const int t = row & 4095; const float pos = (float)(lane < 32 ? (t >> 6) : (t & 63));
        const float ang = pos * invf; const float cs = lat ? __cosf(ang) : 1.0f, sn = lat ? __sinf(ang) : 0.0f;
#pragma unroll 2
        for (int hh = 0; hh < 10; ++hh) {
            bf16_t* hp = pr + hh * 128; const float* g = hh < 8 ? gq : gk;
            const float x1 = bf2f(hp[lane]), x2 = bf2f(hp[64 + lane]);
            const float rstd = __builtin_amdgcn_rsqf(wave_sum(x1 * x1 + x2 * x2) * (1.0f / 128.0f) + EPS);
            const float y1 = x1 * rstd * g[lane], y2 = x2 * rstd * g[64 + lane];
            hp[lane] = (bf16_t)f2bf(y1 * cs - y2 * sn); hp[64 + lane] = (bf16_t)f2bf(y2 * cs + y1 * sn);
        }
    }
}

__device__ __forceinline__ void attn_phase(int kind, const KP& p, int jm, char* lds, int G) {
    unsigned char* ws = p.ws; bf16_t* XN = (bf16_t*)(ws + WS_XN);
    const int bid = blockIdx.x;
#if AEN & 1
    if (kind == 0) {
        const bf16_t* Q = (const bf16_t*)(ws + WS_TMP + T_AQ); const bf16_t* KV = (const bf16_t*)(ws + WS_TMP + T_AKV); const bf16_t* KR = (const bf16_t*)(ws + WS_TMP + T_AKR);
        const int nlat = 1024, ntot = nlat + 64;
        for (int uidx = bid; uidx < ntot; uidx += G) {
            att::AUnit u; int b, h; size_t qrow;
            if (uidx < nlat) { const int rnd = uidx / G, xcd = bid & 7, slot = bid >> 3; const int pair = rnd * 16 + xcd * 2 + (slot >> 4); b = pair >> 3; h = pair & 7; qrow = (size_t)b * SEQ + (size_t)(slot & 15) * 256; u.nt = 68; }
            else { const int c = uidx - nlat; b = c >> 3; h = c & 7; qrow = (size_t)ML + (size_t)b * CTXL; u.nt = 4; }
            const size_t crow0 = (size_t)ML + (size_t)b * CTXL, lrow0 = (size_t)b * SEQ;
            u.q = Q + qrow * 1536 + h * 192;
            u.k1c = KV + crow0 * 2048 + h * 256; u.k1l = KV + lrow0 * 2048 + h * 256;
            u.k2c = KR + crow0 * 64; u.k2l = KR + lrow0 * 64;
            u.vc = u.k1c + 128; u.vl = u.k1l + 128;
            u.o = XN + qrow * 1024 + h * 128; u.nctx = 4; u.C = 0.07216878364870322f * 1.4426950408889634f;
            u.R0 = 0; u.klo = 0; u.rpb = nullptr;
            att::attn_unit<192, 128, 0, 1, 1536, 2048, 64, 2048, 1024>(u, lds);
        }
    }
#endif
#if AEN & 2
    if (kind == 1) {
        const bf16_t* PR = (const bf16_t*)(ws + WS_TMP + T_PROJ);
        const int nlat = 1024, ntot = nlat + 64;
        for (int uidx = bid; uidx < ntot; uidx += G) {
            att::AUnit u; int b, h; size_t qrow;
            if (uidx < nlat) { const int rnd = uidx / G, xcd = bid & 7, slot = bid >> 3; const int pair = rnd * 16 + xcd * 2 + (slot >> 4); b = pair >> 3; h = pair & 7; qrow = (size_t)b * SEQ + (size_t)(slot & 15) * 256; u.nt = 68; }
            else { const int c = uidx - nlat; b = c >> 3; h = c & 7; qrow = (size_t)ML + (size_t)b * CTXL; u.nt = 4; }
            const int kvh = h >> 2;
            const size_t crow0 = (size_t)ML + (size_t)b * CTXL, lrow0 = (size_t)b * SEQ;
            u.q = PR + qrow * 1536 + h * 128;
            u.k1c = PR + crow0 * 1536 + 1024 + kvh * 128; u.k1l = PR + lrow0 * 1536 + 1024 + kvh * 128;
            u.k2c = nullptr; u.k2l = nullptr;
            u.vc = u.k1c + 256; u.vl = u.k1l + 256;
            u.o = XN + qrow * 1024 + h * 128; u.nctx = 4; u.C = 0.08838834764831845f * 1.4426950408889634f;
            u.R0 = 0; u.klo = 0; u.rpb = nullptr;
            att::attn_unit<128, 128, 0, 2, 1536, 1536, 64, 1536, 1024>(u, lds);
        }
    }
#endif
#if AEN & 4
    if (kind == 2) {
        const bf16_t* PR = (const bf16_t*)(ws + WS_TMP + T_PROJ);
        const float* rpb = p.in[22] + (size_t)jm * 16 * 15 * 31;
        const int nlat = 2048, ntot = nlat + 128;
        for (int uidx = bid; uidx < ntot; uidx += G) {
            att::AUnit u; int b, h; size_t qrow; u.R0 = 0; u.klo = 0;
            if (uidx < nlat) { const int rnd = uidx / G, xcd = bid & 7, slot = bid >> 3; const int pair = rnd * 16 + xcd * 2 + (slot >> 4); b = pair >> 4; h = pair & 15;
                const int R0 = (slot & 15) * 4; qrow = (size_t)b * SEQ + (size_t)R0 * 64;
                int klo = R0 - 4; klo = klo < 0 ? 0 : (klo > 56 ? 56 : klo);
                int khi = R0 - 1; khi = khi < 0 ? 0 : (khi > 56 ? 56 : khi); khi += 7;
                if (((khi - klo + 1) & 1) != 0) { if (khi < 63) ++khi; else --klo; }
                u.R0 = R0; u.klo = klo; u.nt = 4 + (khi - klo + 1); }
            else { const int c = uidx - nlat; b = c >> 4; h = c & 15; qrow = (size_t)ML + (size_t)b * CTXL; u.nt = 4; }
            const size_t crow0 = (size_t)ML + (size_t)b * CTXL, lrow0 = (size_t)b * SEQ + (size_t)u.klo * 64;
            u.q = PR + qrow * 3072 + h * 64;
            u.k1c = PR + crow0 * 3072 + 1024 + h * 64; u.k1l = PR + lrow0 * 3072 + 1024 + h * 64;
            u.k2c = nullptr; u.k2l = nullptr;
            u.vc = u.k1c + 1024; u.vl = u.k1l + 1024;
            u.o = XN + qrow * 1024 + h * 64; u.nctx = 4; u.C = 0.125f * 1.4426950408889634f;
            u.rpb = rpb + (size_t)h * 15 * 31;
            att::attn_unit<64, 64, 1, 2, 3072, 3072, 64, 3072, 1024>(u, lds);
        }
    }
#endif
}

enum { T_SKIP = 0, T_NORM, T_UP, T_RES, T_PLAIN, T_ELT_A1, T_ELT_A2, T_ELT_B, T_ATTN };

__global__ void __launch_bounds__(512, 2) fwd_mega(KP p, int ph_lo, int ph_hi) {
    extern __shared__ __attribute__((aligned(16))) unsigned char lds_raw[];
    cg::grid_group grid = cg::this_grid();
    LAS unsigned char* lds = (LAS unsigned char*)lds_raw;
    const int G = gridDim.x, NGW = G * 8;
    unsigned char* ws = p.ws;
    bf16_t* Wb = (bf16_t*)(ws + WS_W); bf16_t* XN = (bf16_t*)(ws + WS_XN); float* XC = (float*)(ws + WS_XC); float* MOD = (float*)(ws + WS_MOD);
    unsigned char* tmp = ws + WS_TMP;
    int phase = 0;
#define SEAM() do { ++phase; if (phase > ph_lo && phase < ph_hi) grid.sync(); } while (0)
#define ACTIVE() (phase >= ph_lo && phase < ph_hi)
#if EN & 64
    if (ACTIVE()) { int tl_ = threadIdx.x; asm volatile("" : "+v"(tl_)); prologue_phase(p, lds, tl_, tl_ & 63, __builtin_amdgcn_readfirstlane(tl_ >> 6), G); }
#endif
    SEAM();
    for (int l = 0; l < DEPTH; ++l) {
        const int kind = l % 3, jm = l / 3;
        const float* modl = MOD + (size_t)l * 9 * 9216;
        bf16_t* WL = Wb + (size_t)l * W_LAYER;
        for (int s = 0; s < 13; ++s) {
            int type;
            switch (s) {
            case 0: case 3: case 10: type = T_NORM; break;
            case 1: case 11: type = T_UP; break;
            case 2: case 9: case 12: type = T_RES; break;
            case 4: type = T_PLAIN; break;
            case 5: type = kind == 0 ? T_ELT_A1 : (kind == 1 ? T_ELT_B : T_SKIP); break;
            case 6: type = kind == 0 ? T_PLAIN : T_SKIP; break;
            case 7: type = kind == 0 ? T_ELT_A2 : T_SKIP; break;
            default: type = T_ATTN; break;
            }
            if (type == T_SKIP) continue;
            if (ACTIVE()) {
                int tl_ = threadIdx.x; asm volatile("" : "+v"(tl_)); const int lane = tl_ & 63; const int gw = blockIdx.x * 8 + __builtin_amdgcn_readfirstlane(tl_ >> 6);
                const bool first = (l == 0 && s <= 2);
                const float* xsL = first ? p.in[0] : p.out; const float* xsC = first ? p.in[2] : XC;
                switch (type) {
#if EN & 1
                case T_NORM: { const int which = s == 0 ? 0 : (s == 3 ? 1 : 2);
                    norm_phase(xsL, xsC, p.in[4] + (size_t)(l * 3 + which) * DM, modl + (3 * which) * DM, modl + (3 * which + 1) * DM, XN, gw, NGW, lane); } break;
#endif
#if EN & 2
                case T_UP: { pg8::Gemm g{XN, WL + (s == 1 ? W_13A : W_13B), MT, 2 * DFF, DM}; pg8::StaticOrder S; S.init(MT, 2 * DFF, G, (int)blockIdx.x);
                    pg8::EpiSwiglu E{(bf16_t*)(tmp + T_ACT), DFF};
                    pg8::gemm_phase<pg8::EpiSwiglu, pg8::StaticOrder, true, true>(lds, g, S, E); } break;
#endif
#if EN & 4
                case T_RES: { const bf16_t* gA; const bf16_t* gB; int gK; const float* gate; float gf;
                    if (s == 9) { gA = XN; gK = 1024; gate = modl + 5 * DM; gf = 1.0f;
                        gB = kind == 0 ? Wb + W_MX + (size_t)jm * W_ASZ + W_A_O : (kind == 1 ? Wb + W_MXB + W_B_O : Wb + W_MXC + W_C_O); }
                    else { gA = (const bf16_t*)(tmp + T_ACT); gK = DFF; gf = 0.5f; gate = modl + (s == 2 ? 2 : 8) * DM; gB = WL + (s == 2 ? W_2A : W_2B); }
                    pg8::Gemm g{gA, gB, MT, DM, gK}; pg8::StaticOrder S; S.init(MT, DM, G, (int)blockIdx.x);
                    pg8::EpiRes E{xsL, xsC, p.out, XC, gate, gf};
                    pg8::gemm_phase<pg8::EpiRes, pg8::StaticOrder, true, true>(lds, g, S, E); } break;
#endif
#if EN & 8
                case T_PLAIN: {
                    const int ngem = s == 6 ? 2 : 1;
                    for (int gi = 0; gi < ngem; ++gi) {
                        const bf16_t* gA; const bf16_t* gB; int gN, gK; bf16_t* gO;
                        if (s == 4) { gA = XN; gK = 1024;
                            if (kind == 0)      { gB = Wb + W_MX + (size_t)jm * W_ASZ + W_A_IN; gN = 768; gO = (bf16_t*)(tmp + T_APROJ); }
                            else if (kind == 1) { gB = Wb + W_MXB + W_B_QKV; gN = 1536; gO = (bf16_t*)(tmp + T_PROJ); }
                            else                { gB = Wb + W_MXC + W_C_QKV; gN = 3072; gO = (bf16_t*)(tmp + T_PROJ); } }
                        else if (gi == 0) { gA = (const bf16_t*)(tmp + T_ACQN); gB = Wb + W_MX + (size_t)jm * W_ASZ + W_A_UQ; gN = 1536; gK = 384; gO = (bf16_t*)(tmp + T_AQ); }
                        else { gA = (const bf16_t*)(tmp + T_ACKVN); gB = Wb + W_MX + (size_t)jm * W_ASZ + W_A_UKV; gN = 2048; gK = 256; gO = (bf16_t*)(tmp + T_AKV); }
                        pg8::Gemm g{gA, gB, MT, gN, gK}; pg8::StaticOrder S; S.init(MT, gN, G, (int)blockIdx.x);
                        pg8::EpiBf16<0> E{gO, gN, nullptr, 0, 0, 1.f};
                        pg8::gemm_phase<pg8::EpiBf16<0>, pg8::StaticOrder, true, true>(lds, g, S, E);
                        __syncthreads();
                    } } break;
#endif
#if EN & 16
                case T_ELT_A1: mla_norm_phase((const bf16_t*)(tmp + T_APROJ), p.in[12] + (size_t)jm * 384, p.in[13] + (size_t)jm * 256,
                                              (bf16_t*)(tmp + T_ACQN), (bf16_t*)(tmp + T_ACKVN), (bf16_t*)(tmp + T_AKR), gw, NGW, lane); break;
                case T_ELT_A2: mla_qrope_phase((bf16_t*)(tmp + T_AQ), gw, NGW, lane); break;
                case T_ELT_B: gqa_normrope_phase((bf16_t*)(tmp + T_PROJ), p.in[18] + (size_t)jm * 128, p.in[19] + (size_t)jm * 128, gw, NGW, lane); break;
#endif
#if EN & 32
                case T_ATTN: attn_phase(kind, p, jm, (char*)lds_raw, G); break;
#endif
                default: break;
                }
            }
            SEAM();
        }
    }
    if (ACTIVE()) { int tl_ = threadIdx.x; asm volatile("" : "+v"(tl_)); final_norm_phase(p.out, p.in[24], blockIdx.x * 8 + __builtin_amdgcn_readfirstlane(tl_ >> 6), NGW, tl_ & 63); }
#undef SEAM
#undef ACTIVE
}

extern "C" void kernel_launch(void* const* d_in, const int* in_sizes, int n_in, void* d_out, int out_size, void* d_ws, size_t ws_size, hipStream_t stream) {
    static int grid = 0;
    if (grid == 0) {
        if (n_in != 25 || out_size != ML * DM || ws_size < WS_END) { fprintf(stderr, "kernel_launch: unexpected shapes: n_in %d out %d ws %zu (need %zu)\n", n_in, out_size, ws_size, (size_t)WS_END); grid = -1; return; }
        int dev = 0, cus = 0, per_cu = 0;
        hipGetDevice(&dev); hipDeviceGetAttribute(&cus, hipDeviceAttributeMultiprocessorCount, dev);
        if (hipFuncSetAttribute((const void*)fwd_mega, hipFuncAttributeMaxDynamicSharedMemorySize, LDS_BYTES) != hipSuccess) { fprintf(stderr, "kernel_launch: hipFuncSetAttribute failed\n"); grid = -1; return; }
        if (hipOccupancyMaxActiveBlocksPerMultiprocessor(&per_cu, (const void*)fwd_mega, 512, LDS_BYTES) != hipSuccess || per_cu < 1) { fprintf(stderr, "kernel_launch: occupancy query says %d\n", per_cu); per_cu = 1; }
        (void)hipGetLastError();
        grid = cus;
        fprintf(stderr, "kernel_launch: grid %d (cus %d, per_cu %d)\n", grid, cus, per_cu);
    }
    if (grid < 0) return;
    KP p{};
    for (int i = 0; i < 25; ++i) p.in[i] = (const float*)d_in[i];
    p.out = (float*)d_out; p.ws = (unsigned char*)d_ws;
#ifndef N_LAUNCH_SPLIT
    int lo = 0, hi = 1 << 30;
    void* args[] = {&p, &lo, &hi};
    hipError_t e = hipLaunchCooperativeKernel((const void*)fwd_mega, dim3(grid), dim3(512), args, LDS_BYTES, stream);
    if (e != hipSuccess) fprintf(stderr, "cooperative launch failed: %s (grid %d)\n", hipGetErrorString(e), grid);
#else
    const int nph = 2 + DEPTH * 13;
    for (int ph = 0; ph < nph; ++ph) { int lo = ph, hi = ph + 1; void* args[] = {&p, &lo, &hi};
        hipError_t e = hipLaunchCooperativeKernel((const void*)fwd_mega, dim3(grid), dim3(512), args, LDS_BYTES, stream);
        if (e != hipSuccess) { fprintf(stderr, "launch %d failed: %s\n", ph, hipGetErrorString(e)); break; } }
#endif
}
```

```cpp
#include <hip/hip_runtime.h>
#include <hip/hip_bf16.h>
#include <hip/hip_cooperative_groups.h>
#include <cstdio>
#include <cstdint>
namespace cg = cooperative_groups;
typedef unsigned short bf16_t;
constexpr int DM = 1024, NB = 8, SEQ = 4096, ML = NB * SEQ, CTXL = 256, MC = NB * CTXL, MT = ML + MC, DFF = 2816, DEPTH = 4;
constexpr float EPS = 1e-6f;
constexpr float LOG2_THETA = 13.287712379549449f;
constexpr size_t MiB = 1u << 20;
constexpr size_t WS_MOD = 1 * MiB, WS_SS = 3 * MiB, WS_GM = 5 * MiB, WS_SWUP = 6 * MiB, WS_SWPR = 8 * MiB, WS_XC = 9 * MiB, WS_W = 17 * MiB, WS_XN = 174 * MiB, WS_TMP = 242 * MiB, WS_END = 532 * MiB;
constexpr size_t T_XG2 = 188 * MiB;
constexpr size_t W_LAYER = 17301504, W_13A = 0, W_2A = 5767168, W_13B = 8650752, W_2B = 14417920;
constexpr size_t W_MX = 69206016, W_ASZ = 2949120, W_A_IN = 0, W_A_UQ = 786432, W_A_UKV = 1376256, W_A_O = 1900544;
constexpr size_t W_MXB = W_MX + 2 * W_ASZ, W_B_QKV = 0, W_B_O = 1572864;
constexpr size_t W_MXC = W_MXB + 2621440, W_C_QKV = 0, W_C_O = 3145728;
static_assert(W_MXC + 4194304 == 81920000 && WS_W + 81920000ull * 2 <= WS_XN, "weight map");
constexpr size_t T_ACT = 0;
constexpr size_t T_AQ = 0, T_ACQN = 102 * MiB, T_ACKVN = 128 * MiB, T_AKR = 146 * MiB, T_AKV = 152 * MiB, T_APROJ = 152 * MiB;
constexpr size_t T_PROJ = 0;
static_assert(WS_TMP + T_AKV + (size_t)MT * 2048 * 2 <= WS_END && WS_TMP + (size_t)MT * 3072 * 2 <= WS_END, "tmp map");
constexpr int LDS_BYTES = 147456;

struct KP { const float* in[25]; float* out; unsigned char* ws; };


#define KARGS() ({ const __attribute__((address_space(4))) KP* kp_ = (const __attribute__((address_space(4))) KP*)__builtin_amdgcn_kernarg_segment_ptr(); asm volatile("" : "+s"(kp_)); kp_; })
namespace pg8 {
#define PG8_LAS __attribute__((address_space(3)))
typedef unsigned short bf16_t;
typedef short bf16x8 __attribute__((ext_vector_type(8)));
typedef float f32x4 __attribute__((ext_vector_type(4)));
typedef unsigned u32x4 __attribute__((ext_vector_type(4)));
typedef unsigned u32x2 __attribute__((ext_vector_type(2)));
constexpr int BM = 256, BK = 64, HALF = 128, HTB = HALF * BK * 2  , STAGE_BYTES = 8 * HTB, NXCD = 8, WGM = 8;

__host__ __device__ __forceinline__ int lds_byte(int r, int c) { const int st = (r >> 4) * 2 + (c >> 5), rr = r & 15, cc = c & 31, ob = rr * 64 + cc * 2; return st * 1024 + (ob ^ (((ob >> 9) & 1) << 5)); }
__host__ __device__ __forceinline__ void stage_rc(int b, int& R, int& C) { const int st = b / 1024, sb = b % 1024, swz = sb ^ (((sb >> 9) & 1) << 5); R = (st >> 1) * 16 + swz / 64; C = (st & 1) * 32 + (swz % 64) / 2; }
__host__ __device__ __forceinline__ int perm32(int rho) { const int n = rho >> 4, i = rho & 15; return 8 * (i >> 2) + 4 * n + (i & 3); }

struct Unit { int pm, pn, kt0, nt, part; };
struct Gemm { const bf16_t* A; const bf16_t* Bt; int M, N, K; };

struct StaticOrder {
    int nM, nN, nwg, G, c, ntk, split;
    __host__ __device__ void init(int M, int N, int G_, int c_, int K_ = 0, int split_ = 0) { nM = M / BM; nN = N / BM; nwg = nM * nN; G = G_; c = c_; ntk = K_ / BK; split = split_; }
    __host__ __device__ void map(int wgid, Unit& u) const {
        { const int q = nwg / NXCD, r = nwg % NXCD, xcd = wgid % NXCD, off = wgid / NXCD; wgid = (xcd < r ? xcd * (q + 1) : r * (q + 1) + (xcd - r) * q) + off; }
        const int nig = WGM * nN, gid = wgid / nig, fm = gid * WGM, gsz = (nM - fm) < WGM ? (nM - fm) : WGM;
        u.pm = fm + ((wgid % nig) % gsz); u.pn = (wgid % nig) / gsz;
    }
    __host__ __device__ bool next(int i, Unit& u) const {
        const long L = (long)i * G + c;
        const int nfull = split ? (nwg / G) * G : nwg;
        if (L < nfull) { map((int)L, u); u.kt0 = 0; u.nt = ntk; u.part = 0; return true; }
        if (!split || i != nwg / G) return false;
        const int rem = nwg - nfull, ways = G / rem, j = c / ways, kp = c % ways;
        if (j >= rem) return false;
        const int P = ntk / 2, p0 = kp * P / ways, p1 = (kp + 1) * P / ways;
        if (p1 <= p0) return false;
        map(nfull + j, u); u.kt0 = 2 * p0; u.nt = 2 * (p1 - p0); u.part = 1; return true;
    }
    __device__ __forceinline__ void a_ready(const Unit&) const {}
    __device__ __forceinline__ void done(const Unit&) const {}
};

__device__ __forceinline__ unsigned cvt_pk_bf16(float lo, float hi) { unsigned r; asm volatile("v_cvt_pk_bf16_f32 %0, %1, %2" : "=v"(r) : "v"(lo), "v"(hi)); return r; }
typedef float f32x2 __attribute__((ext_vector_type(2)));
__device__ __forceinline__ f32x2 gelu_pk(f32x2 v) {
    const f32x2 av = __builtin_elementwise_abs(v), d = av * 0.2316418882f + 1.0f;
    f32x2 t; t.x = __builtin_amdgcn_rcpf(d.x); t.y = __builtin_amdgcn_rcpf(d.y);
    f32x2 q = t * 0.5307027145f + (-0.7265760135f); q = q * t + 0.7107068705f; q = q * t + (-0.142248368f); q = q * t + 0.127414796f; q = q * t;
    const f32x2 s = (v * v) * (-0.72134752044f);
    f32x2 e; e.x = __builtin_amdgcn_exp2f(s.x); e.y = __builtin_amdgcn_exp2f(s.y);
    const f32x2 m = v * (q * e), r = v - m;
    f32x2 o; o.x = v.x < 0.f ? m.x : r.x; o.y = v.y < 0.f ? m.y : r.y; return o;
}

template <int ACT  > struct EpiBf16 {
    static constexpr bool PERM = true, AFTER_DRAIN = false; static_assert(ACT == 0 || ACT == 1, "EpiBf16: ACT is 0 (none) or 1 (gelu_pk)");
    bf16_t* O; int ldc; const float* bias; int split_cols; size_t split_stride; float scale0;
    __device__ __forceinline__ void operator()(const f32x4 (&acc)[2][2][4][2], const Unit& u, int wr, int wc, int fr, int fq) const {
        const int row0 = u.pm * BM + wr * 64 + fr; int colt = u.pn * BM; bf16_t* base = O;
        float sc = 1.f; if (split_cols) { const int t = colt / split_cols; base += (size_t)t * split_stride; colt -= t * split_cols; if (t == 0) sc = scale0; }
        const int col0 = colt + wc * 32 + 8 * fq, bcol0 = u.pn * BM + wc * 32 + 8 * fq;
        f32x4 bv[2][2];
#pragma unroll
        for (int bj = 0; bj < 2; ++bj)
#pragma unroll
            for (int n = 0; n < 2; ++n) bv[bj][n] = bias ? *(const f32x4*)(bias + bcol0 + bj * HALF + 4 * n) : (f32x4){0.f, 0.f, 0.f, 0.f};
#pragma unroll
        for (int ai = 0; ai < 2; ++ai)
#pragma unroll
            for (int m = 0; m < 4; ++m) { bf16_t* rowp = base + (size_t)(row0 + ai * HALF + m * 16) * ldc + col0;
#pragma unroll
                for (int bj = 0; bj < 2; ++bj) { f32x4 v0 = acc[ai][bj][m][0] + bv[bj][0], v1 = acc[ai][bj][m][1] + bv[bj][1];
                    if (ACT == 1) { f32x2 a = gelu_pk((f32x2){v0[0], v0[1]}), b = gelu_pk((f32x2){v0[2], v0[3]}), c = gelu_pk((f32x2){v1[0], v1[1]}), d = gelu_pk((f32x2){v1[2], v1[3]});
                        v0 = (f32x4){a.x, a.y, b.x, b.y}; v1 = (f32x4){c.x, c.y, d.x, d.y}; }
                    v0 = v0 * sc; v1 = v1 * sc; u32x4 w; w.x = cvt_pk_bf16(v0[0], v0[1]); w.y = cvt_pk_bf16(v0[2], v0[3]); w.z = cvt_pk_bf16(v1[0], v1[1]); w.w = cvt_pk_bf16(v1[2], v1[3]);
                    *(u32x4*)(rowp + bj * HALF) = w; } }
    }
};

__device__ __forceinline__ float silu_f(float g) { return g * __builtin_amdgcn_rcpf(1.0f + __builtin_amdgcn_exp2f(-1.4426950408889634f * g)); }
constexpr float NEPS = 1e-6f;
struct EpiSwiglu {
    static constexpr bool PERM = true, AFTER_DRAIN = false;
    int l, half;
    __device__ __forceinline__ void operator()(const f32x4 (&acc)[2][2][4][2], const Unit& u, int wr, int wc, int fr, int fq) const {
        const auto kp = KARGS(); unsigned char* ws = kp->ws;
        bf16_t* O = (bf16_t*)(ws + WS_TMP + T_ACT); constexpr int ldc = DFF; const float* SS = (const float*)(ws + WS_SS) + (size_t)(l * 3 + (half ? 2 : 0)) * MT;
        const float* SW = (const float*)(ws + WS_SWUP) + (size_t)(l * 2 + half) * 9 * 5632;
        const int row0 = u.pm * BM + wr * 64 + fr; const int col0 = u.pn * HALF + wc * 32 + 8 * fq;
        const int mb = u.pm < 128 ? (u.pm >> 4) : 8;
        const float* swp = SW + (size_t)mb * 5632 + col0;
        const f32x4 sg0 = *(const f32x4*)swp, sg1 = *(const f32x4*)(swp + 4), su0 = *(const f32x4*)(swp + 2816), su1 = *(const f32x4*)(swp + 2820);
#pragma unroll
        for (int ai = 0; ai < 2; ++ai)
#pragma unroll
            for (int m = 0; m < 4; ++m) { const int row = row0 + ai * HALF + m * 16; bf16_t* rowp = O + (size_t)row * ldc + col0;
                const float rstd = __builtin_amdgcn_rsqf(SS[row] * (1.0f / 1024.0f) + NEPS);
                const f32x4 g0 = acc[ai][0][m][0] * rstd + sg0, g1 = acc[ai][0][m][1] * rstd + sg1, u0 = acc[ai][1][m][0] * rstd + su0, u1 = acc[ai][1][m][1] * rstd + su1;
                f32x4 v0, v1;
#pragma unroll
                for (int i = 0; i < 4; ++i) { v0[i] = silu_f(g0[i]) * u0[i]; v1[i] = silu_f(g1[i]) * u1[i]; }
                u32x4 w; w.x = cvt_pk_bf16(v0[0], v0[1]); w.y = cvt_pk_bf16(v0[2], v0[3]); w.z = cvt_pk_bf16(v1[0], v1[1]); w.w = cvt_pk_bf16(v1[2], v1[3]);
                *(u32x4*)rowp = w; }
    }
};
struct EpiBf16N {
    static constexpr bool PERM = true, AFTER_DRAIN = false;
    bf16_t* O; int ldc; int ssidx, l;
    __device__ __forceinline__ void operator()(const f32x4 (&acc)[2][2][4][2], const Unit& u, int wr, int wc, int fr, int fq) const {
        const auto kp = KARGS(); unsigned char* ws = kp->ws;
        const float* SS = ssidx >= 0 ? (const float*)(ws + WS_SS) + (size_t)ssidx * MT : nullptr; const float* SW = (const float*)(ws + WS_SWPR) + (size_t)l * 9 * 3072; constexpr int ldsw = 3072;
        const int row0 = u.pm * BM + wr * 64 + fr; const int col0 = u.pn * BM + wc * 32 + 8 * fq;
        const int mb = u.pm < 128 ? (u.pm >> 4) : 8;
        f32x4 bv[2][2];
#pragma unroll
        for (int bj = 0; bj < 2; ++bj)
#pragma unroll
            for (int n = 0; n < 2; ++n) bv[bj][n] = SS ? *(const f32x4*)(SW + (size_t)mb * ldsw + col0 + bj * HALF + 4 * n) : (f32x4){0.f, 0.f, 0.f, 0.f};
#pragma unroll
        for (int ai = 0; ai < 2; ++ai)
#pragma unroll
            for (int m = 0; m < 4; ++m) { const int row = row0 + ai * HALF + m * 16; bf16_t* rowp = O + (size_t)row * ldc + col0;
                const float rstd = SS ? __builtin_amdgcn_rsqf(SS[row] * (1.0f / 1024.0f) + NEPS) : 1.0f;
#pragma unroll
                for (int bj = 0; bj < 2; ++bj) { const f32x4 v0 = acc[ai][bj][m][0] * rstd + bv[bj][0], v1 = acc[ai][bj][m][1] * rstd + bv[bj][1];
                    u32x4 w; w.x = cvt_pk_bf16(v0[0], v0[1]); w.y = cvt_pk_bf16(v0[2], v0[3]); w.z = cvt_pk_bf16(v1[0], v1[1]); w.w = cvt_pk_bf16(v1[2], v1[3]);
                    *(u32x4*)(rowp + bj * HALF) = w; } }
    }
};
struct EpiRes {
    static constexpr bool PERM = false, AFTER_DRAIN = false;
    int l, s;
    __device__ __forceinline__ void operator()(const f32x4 (&acc)[2][2][4][2], const Unit& u, int wr, int wc, int fr, int fq) const {
        const auto kp = KARGS(); unsigned char* ws = kp->ws;
        const bool first = (l == 0 && s == 2);
        float* dstL = kp->out; float* dstC = (float*)(ws + WS_XC);
        const float* srcL = first ? kp->in[0] : dstL; const float* srcC = first ? kp->in[2] : dstC;
        const float* gate = (const float*)(ws + WS_MOD) + (size_t)l * 9 * 9216 + (s == 2 ? 2 : (s == 9 ? 5 : 8)) * 1024; const float f = s == 9 ? 1.0f : 0.5f;
        const int nxt = s == 2 ? l * 3 + 1 : (s == 9 ? l * 3 + 2 : l * 3 + 3);
        const float* gm = nxt < 12 ? (const float*)(ws + WS_GM) + (size_t)nxt * 9 * 1024 : nullptr;
        bf16_t* XG = s == 9 ? (bf16_t*)(ws + WS_TMP + T_XG2) : (bf16_t*)(ws + WS_XN); float* SS = (float*)(ws + WS_SS) + (size_t)(nxt < 12 ? nxt : 0) * MT;
        const int pm = u.pm; const int mb = pm < 128 ? (pm >> 4) : 8;
        const float* src = pm < 128 ? srcL + (size_t)pm * 256 * 1024 : srcC + (size_t)(pm - 128) * 256 * 1024;
        float* dst = pm < 128 ? dstL + (size_t)pm * 256 * 1024 : dstC + (size_t)(pm - 128) * 256 * 1024;
        const float* gp = gate + (size_t)mb * 9216;
        const int col0 = u.pn * BM + wc * 32 + 4 * fq;
        f32x4 gv[2][2], gmv[2][2];
#pragma unroll
        for (int bj = 0; bj < 2; ++bj)
#pragma unroll
            for (int n = 0; n < 2; ++n) { gv[bj][n] = *(const f32x4*)(gp + col0 + bj * HALF + n * 16) * f;
                gmv[bj][n] = gm ? *(const f32x4*)(gm + (size_t)mb * 1024 + col0 + bj * HALF + n * 16) : (f32x4){0.f, 0.f, 0.f, 0.f}; }
#pragma unroll
        for (int ai = 0; ai < 2; ++ai)
#pragma unroll
            for (int m = 0; m < 4; ++m) { const int r = ai * HALF + wr * 64 + m * 16 + fr; const size_t off = (size_t)r * 1024 + col0; float ss = 0.f;
#pragma unroll
                for (int bj = 0; bj < 2; ++bj)
#pragma unroll
                    for (int n = 0; n < 2; ++n) { const f32x4 b = *(const f32x4*)(src + off + bj * HALF + n * 16);
                        const f32x4 o = b + gv[bj][n] * acc[ai][bj][m][n];
                        *(f32x4*)(dst + off + bj * HALF + n * 16) = o;
                        if (gm) { ss += (o[0] * o[0] + o[1] * o[1]) + (o[2] * o[2] + o[3] * o[3]); const f32x4 xg = o * gmv[bj][n];
                            u32x2 w; w.x = cvt_pk_bf16(xg[0], xg[1]); w.y = cvt_pk_bf16(xg[2], xg[3]);
                            *(u32x2*)(XG + (size_t)pm * 256 * 1024 + off + bj * HALF + n * 16) = w; } }
                if (gm) { ss += __shfl_xor(ss, 16); ss += __shfl_xor(ss, 32);
                    if (fq == 0) __hip_atomic_fetch_add(SS + pm * 256 + r, ss, __ATOMIC_RELAXED, __HIP_MEMORY_SCOPE_AGENT); } }
    }
};
template <class Epi, class Sched, bool ALIGN_EPI = false, bool SP2 = false>
__device__ __forceinline__ void gemm_phase(PG8_LAS unsigned char* lds, const Gemm g, const Sched& S, const Epi& E) {
    int tid_ = threadIdx.x; asm volatile("" : "+v"(tid_)); const int tid = tid_, wid = __builtin_amdgcn_readfirstlane(tid >> 6), lane = tid & 63, wr = wid >> 2, wc = wid & 3, fr = lane & 15, fq = lane >> 4;
    const int K = g.K;
    unsigned voffA[2], voffB[2];
#pragma unroll
    for (int i = 0; i < 2; ++i) { int R, C; stage_rc(tid * 16 + i * 8192, R, C); const int Rb = Epi::PERM ? ((R & ~31) + perm32(R & 31)) : R;
        voffA[i] = (unsigned)(R * K + C) * 2u; voffB[i] = (unsigned)(Rb * K + C) * 2u; }
    const size_t kstep = (size_t)(BK * 2);
    const size_t hstep = (size_t)HALF * K * 2;
    const size_t tstep = 2 * hstep;
    const unsigned ldsw = (unsigned)wid * 1024u;
    const int aoff = lds_byte(wr * 64 + fr, fq * 8), boff = lds_byte(wc * 32 + fr, fq * 8);
#define PG8_SA(b, h) (((b) * 2 + (h)) * HTB)
#define PG8_SB(b, h) ((4 + (b) * 2 + (h)) * HTB)
#define PG8_STAGE(bufoff, gbase, voff) do { _Pragma("unroll") for (int _i = 0; _i < 2; ++_i) \
        __builtin_amdgcn_global_load_lds((const unsigned*)((const char*)(gbase) + (voff)[_i]), (PG8_LAS unsigned*)(lds + (bufoff) + ldsw + _i * 8192), 16, 0, 0); } while (0)
#define PG8_LDA(dst, b, h) do { _Pragma("unroll") for (int m = 0; m < 4; ++m) _Pragma("unroll") for (int k = 0; k < 2; ++k) dst[m][k] = *(const PG8_LAS bf16x8*)(lds + PG8_SA(b, h) + aoff + m * 2048 + k * 1024); } while (0)
#define PG8_LDB(dst, b, h) do { _Pragma("unroll") for (int n = 0; n < 2; ++n) _Pragma("unroll") for (int k = 0; k < 2; ++k) dst[n][k] = *(const PG8_LAS bf16x8*)(lds + PG8_SB(b, h) + boff + n * 2048 + k * 1024); } while (0)
#define PG8_MMA(ai, bj, At, Bt) do { __builtin_amdgcn_s_setprio(1); _Pragma("unroll") for (int m = 0; m < 4; ++m) _Pragma("unroll") for (int n = 0; n < 2; ++n) _Pragma("unroll") for (int k = 0; k < 2; ++k) \
        acc[ai][bj][m][n] = __builtin_amdgcn_mfma_f32_16x16x32_bf16(Bt[n][k], At[m][k], acc[ai][bj][m][n], 0, 0, 0); __builtin_amdgcn_s_setprio(0); } while (0)
#define PG8_WAIT_V(n) asm volatile("s_waitcnt vmcnt(" #n ")" ::: "memory")
#define PG8_WAIT_L(n) asm volatile("s_waitcnt lgkmcnt(" #n ")" ::: "memory")
#define PG8_BAR __builtin_amdgcn_s_barrier()
#define PG8_SCHED __builtin_amdgcn_sched_barrier(0)
    Unit cur, nxt; int ui = 0;
    if (!S.next(0, cur)) return;
    f32x4 acc[2][2][4][2];
#pragma unroll
    for (int a = 0; a < 2; ++a)
#pragma unroll
        for (int b = 0; b < 2; ++b)
#pragma unroll
            for (int m = 0; m < 4; ++m)
#pragma unroll
                for (int n = 0; n < 2; ++n) acc[a][b][m][n] = (f32x4){0.f, 0.f, 0.f, 0.f};
    bf16x8 At[4][2], B0[2][2], B1[2][2];
    const char* cA = (const char*)g.A + (size_t)cur.pm * tstep + (size_t)cur.kt0 * kstep; const char* cB = (const char*)g.Bt + (size_t)cur.pn * tstep + (size_t)cur.kt0 * kstep;
    S.a_ready(cur);
    if constexpr (SP2) {
        PG8_STAGE(PG8_SB(0, 0), cB, voffB); PG8_STAGE(PG8_SB(0, 1), cB + hstep, voffB); PG8_STAGE(PG8_SA(0, 0), cA, voffA); PG8_STAGE(PG8_SA(0, 1), cA + hstep, voffA);
        if (wr == 1) PG8_BAR;
        PG8_WAIT_V(2); PG8_BAR;
        PG8_STAGE(PG8_SB(1, 0), cB + kstep, voffB); PG8_STAGE(PG8_SA(1, 0), cA + kstep, voffA); PG8_STAGE(PG8_SB(1, 1), cB + hstep + kstep, voffB);
        PG8_WAIT_V(6); PG8_BAR;
    } else {
        PG8_STAGE(PG8_SB(0, 0), cB, voffB); PG8_STAGE(PG8_SA(0, 0), cA, voffA); PG8_STAGE(PG8_SB(0, 1), cB + hstep, voffB); PG8_STAGE(PG8_SA(0, 1), cA + hstep, voffA);
        if (wr == 1) PG8_BAR;
        PG8_WAIT_V(4); PG8_BAR;
        PG8_STAGE(PG8_SB(1, 0), cB + kstep, voffB); PG8_STAGE(PG8_SA(1, 0), cA + kstep, voffA); PG8_STAGE(PG8_SB(1, 1), cB + hstep + kstep, voffB);
        PG8_WAIT_V(6); PG8_BAR;
    }
    for (;;) {
        const bool has_next = S.next(ui + 1, nxt);
        const char* nA = has_next ? (const char*)g.A + (size_t)nxt.pm * tstep + (size_t)nxt.kt0 * kstep : cA; const char* nB = has_next ? (const char*)g.Bt + (size_t)nxt.pn * tstep + (size_t)nxt.kt0 * kstep : cB;
        const int nt = cur.nt;
        for (int t = 0; t < nt; t += 2) {
            const bool last = (t == nt - 2);
            const char* a1 = cA + (size_t)(t + 1) * kstep;
            const char* a2 = last ? nA : cA + (size_t)(t + 2) * kstep; const char* b2 = last ? nB : cB + (size_t)(t + 2) * kstep;
            const char* a3 = a2 + kstep; const char* b3 = b2 + kstep;
            if (last && has_next) S.a_ready(nxt);
            if constexpr (SP2) {
            PG8_LDB(B0, 0, 0); PG8_LDB(B1, 0, 1); PG8_SCHED; PG8_LDA(At, 0, 0); PG8_STAGE(PG8_SA(1, 1), a1 + hstep, voffA);
            PG8_WAIT_V(8); PG8_WAIT_L(0); PG8_BAR; PG8_MMA(0, 0, At, B0); PG8_MMA(0, 1, At, B1); PG8_BAR; PG8_SCHED;
            PG8_LDA(At, 0, 1); PG8_STAGE(PG8_SB(0, 0), b2, voffB); PG8_STAGE(PG8_SB(0, 1), b2 + hstep, voffB); PG8_STAGE(PG8_SA(0, 0), a2, voffA);
            PG8_WAIT_V(8); PG8_WAIT_L(0); PG8_BAR; PG8_MMA(1, 0, At, B0); PG8_MMA(1, 1, At, B1); PG8_BAR; PG8_SCHED;
            PG8_LDB(B0, 1, 0); PG8_LDB(B1, 1, 1); PG8_SCHED; PG8_LDA(At, 1, 0); PG8_STAGE(PG8_SA(0, 1), a2 + hstep, voffA);
            PG8_WAIT_V(8); PG8_WAIT_L(0); PG8_BAR; PG8_MMA(0, 0, At, B0); PG8_MMA(0, 1, At, B1); PG8_BAR; PG8_SCHED;
            PG8_LDA(At, 1, 1); PG8_STAGE(PG8_SB(1, 0), b3, voffB); PG8_STAGE(PG8_SB(1, 1), b3 + hstep, voffB); PG8_STAGE(PG8_SA(1, 0), a3, voffA);
            PG8_WAIT_V(8); PG8_WAIT_L(0); PG8_BAR; PG8_MMA(1, 0, At, B0); PG8_MMA(1, 1, At, B1); PG8_BAR; PG8_SCHED;
            } else {
            PG8_LDB(B0, 0, 0); PG8_SCHED; PG8_LDA(At, 0, 0); PG8_STAGE(PG8_SA(1, 1), a1 + hstep, voffA);
            PG8_WAIT_L(8); PG8_BAR; PG8_WAIT_L(0); PG8_MMA(0, 0, At, B0); PG8_BAR; PG8_SCHED;
            PG8_LDB(B1, 0, 1); PG8_STAGE(PG8_SB(0, 0), b2, voffB);
            PG8_BAR; PG8_WAIT_L(0); PG8_MMA(0, 1, At, B1); PG8_BAR;
            PG8_LDA(At, 0, 1); PG8_STAGE(PG8_SA(0, 0), a2, voffA);
            PG8_BAR; PG8_WAIT_L(0); PG8_MMA(1, 0, At, B0); PG8_BAR; PG8_SCHED;
            PG8_STAGE(PG8_SB(0, 1), b2 + hstep, voffB);
            PG8_WAIT_V(6); PG8_BAR; PG8_MMA(1, 1, At, B1); PG8_BAR;
            PG8_LDB(B0, 1, 0); PG8_SCHED; PG8_LDA(At, 1, 0); PG8_STAGE(PG8_SA(0, 1), a2 + hstep, voffA);
            PG8_WAIT_L(8); PG8_BAR; PG8_WAIT_L(0); PG8_MMA(0, 0, At, B0); PG8_BAR; PG8_SCHED;
            PG8_LDB(B1, 1, 1); PG8_STAGE(PG8_SB(1, 0), b3, voffB);
            PG8_BAR; PG8_WAIT_L(0); PG8_MMA(0, 1, At, B1); PG8_BAR;
            PG8_LDA(At, 1, 1); PG8_STAGE(PG8_SA(1, 0), a3, voffA);
            PG8_BAR; PG8_WAIT_L(0); PG8_MMA(1, 0, At, B0); PG8_BAR; PG8_SCHED;
            PG8_STAGE(PG8_SB(1, 1), b3 + hstep, voffB);
            PG8_WAIT_V(6); PG8_BAR; PG8_MMA(1, 1, At, B1); PG8_BAR;
            }
        }
        if constexpr (ALIGN_EPI) { if (wr == 0) PG8_BAR; }
        if constexpr (!Epi::AFTER_DRAIN) { E(acc, cur, wr, wc, fr, fq); S.done(cur); }
        if (!has_next) break;
#pragma unroll
        for (int a = 0; a < 2; ++a)
#pragma unroll
            for (int b = 0; b < 2; ++b)
#pragma unroll
                for (int m = 0; m < 4; ++m)
#pragma unroll
                    for (int n = 0; n < 2; ++n) acc[a][b][m][n] = (f32x4){0.f, 0.f, 0.f, 0.f};
        cur = nxt; cA = nA; cB = nB; ++ui;
        if constexpr (ALIGN_EPI) { if (wr == 1) PG8_BAR; }
    }
    PG8_WAIT_V(0);
    if constexpr (!ALIGN_EPI) { if (wr == 0) PG8_BAR; }
    PG8_BAR;
    if constexpr (Epi::AFTER_DRAIN) { E.fused(acc, cur, wr, wc, fr, fq, lds, wid, lane); S.done(cur); }
#undef PG8_SA
#undef PG8_SB
#undef PG8_STAGE
#undef PG8_LDA
#undef PG8_LDB
#undef PG8_MMA
#undef PG8_WAIT_V
#undef PG8_WAIT_L
#undef PG8_BAR
#undef PG8_SCHED
}
}

namespace att {
typedef unsigned short bf16_t;
using bf16x8 = __attribute__((ext_vector_type(8))) short;
using s16x4  = __attribute__((ext_vector_type(4))) short;
using f32x16 = __attribute__((ext_vector_type(16))) float;
using u32x4  = __attribute__((ext_vector_type(4))) unsigned;
#define SBAR() __builtin_amdgcn_sched_barrier(0)
__device__ __forceinline__ int crow(int r, int hi) { return (r & 3) + 8 * (r >> 2) + 4 * hi; }
__device__ __forceinline__ unsigned cvtpk(float lo, float hi) { unsigned r; asm volatile("v_cvt_pk_bf16_f32 %0, %1, %2" : "=v"(r) : "v"(lo), "v"(hi)); return r; }
__device__ __forceinline__ bf16x8 ld8(const bf16_t* p) { return *reinterpret_cast<const bf16x8*>(p); }
__device__ __forceinline__ unsigned short f2bf1(float f) { unsigned u = __builtin_bit_cast(unsigned, f); return (unsigned short)((u + 0x7fffu + ((u >> 16) & 1u)) >> 16); }

struct AUnit {
  const bf16_t* q;
  const bf16_t* k1c; const bf16_t* k1l;
  const bf16_t* k2c; const bf16_t* k2l;
  const bf16_t* vc; const bf16_t* vl;
  bf16_t* o;
  int nt, nctx; float C;
  int R0, klo; const float* rpb;
};

__device__ __forceinline__ void partialSM(f32x16& p0, f32x16& p1, float& m_reg, float& mn, float& alpha, const float C, const float thr) {
  float pmax = p0[0];
#pragma unroll
  for (int r = 1; r < 16; ++r) pmax = fmaxf(pmax, p0[r]);
#pragma unroll
  for (int r = 0; r < 16; ++r) pmax = fmaxf(pmax, p1[r]);
  { auto rr = __builtin_amdgcn_permlane32_swap(__float_as_uint(pmax), __float_as_uint(pmax), false, false);
    pmax = fmaxf(__uint_as_float(rr[0]), __uint_as_float(rr[1])); }
  if (__builtin_expect(__all(pmax - m_reg <= thr), 1)) { mn = m_reg; alpha = 1.f; }
  else { mn = fmaxf(m_reg, pmax); alpha = __builtin_amdgcn_exp2f((m_reg - mn) * C); m_reg = mn; }
  float mnC = -mn * C;
#pragma unroll
  for (int r = 0; r < 16; ++r) p0[r] = fmaf(p0[r], C, mnC);
#pragma unroll
  for (int r = 0; r < 16; ++r) p1[r] = fmaf(p1[r], C, mnC);
#pragma unroll
  for (int r = 0; r < 16; ++r) p0[r] = __builtin_amdgcn_exp2f(p0[r]);
}
__device__ __forceinline__ void finishSM(f32x16& p0, f32x16& p1, float alpha, float& l_reg, bf16x8& pa0, bf16x8& pa1, bf16x8& pa2, bf16x8& pa3) {
#pragma unroll
  for (int r = 0; r < 16; ++r) p1[r] = __builtin_amdgcn_exp2f(p1[r]);
  float ps = 0;
#pragma unroll
  for (int r = 0; r < 16; ++r) ps += p0[r];
#pragma unroll
  for (int r = 0; r < 16; ++r) ps += p1[r];
  { auto rr = __builtin_amdgcn_permlane32_swap(__float_as_uint(ps), __float_as_uint(ps), false, false);
    ps = __uint_as_float(rr[0]) + __uint_as_float(rr[1]); }
  l_reg = l_reg * alpha + ps;
#define PK4(P, BASE, OUT) do { unsigned a0 = cvtpk(P[BASE + 0], P[BASE + 1]), a1 = cvtpk(P[BASE + 2], P[BASE + 3]);   \
    unsigned b0 = cvtpk(P[BASE + 4], P[BASE + 5]), b1 = cvtpk(P[BASE + 6], P[BASE + 7]);                              \
    auto r0 = __builtin_amdgcn_permlane32_swap(a0, b0, false, false); auto r1 = __builtin_amdgcn_permlane32_swap(a1, b1, false, false); \
    u32x4 w = {r0[0], r1[0], r0[1], r1[1]}; OUT = *reinterpret_cast<bf16x8*>(&w); } while (0)
  PK4(p0, 0, pa0); PK4(p0, 8, pa1); PK4(p1, 0, pa2); PK4(p1, 8, pa3);
#undef PK4
}
template <int DK> __device__ __forceinline__ int kswz(int row, int colB) { return row * (DK * 2) + (colB ^ ((row & 7) << 4)); }
template <int DK> __device__ __forceinline__ void qkt(f32x16& p0, f32x16& p1, const char* Ks, const bf16x8* qr, const char* qlds, int r32, int hi) {
  p0 = f32x16{}; p1 = f32x16{};
#pragma unroll
  for (int d0 = 0; d0 < DK / 16; ++d0) { int cb = (d0 * 16 + hi * 8) * 2;
    bf16x8 b0 = *reinterpret_cast<const bf16x8*>(Ks + kswz<DK>(r32, cb));
    bf16x8 b1 = *reinterpret_cast<const bf16x8*>(Ks + kswz<DK>(32 + r32, cb));
    bf16x8 qf;
    if (DK == 192 && d0 >= 8) qf = *reinterpret_cast<const bf16x8*>(qlds + (d0 - 8) * 1024); else qf = qr[d0 < 8 ? d0 : 0];
    p0 = __builtin_amdgcn_mfma_f32_32x32x16_bf16(b0, qf, p0, 0, 0, 0);
    p1 = __builtin_amdgcn_mfma_f32_32x32x16_bf16(b1, qf, p1, 0, 0, 0); }
}
template <int DV> __device__ __forceinline__ int v_st(int k, int c) { const int kk = (k & ~0xC) | ((k & 4) << 1) | ((k & 8) >> 1); return ((kk >> 3) * (DV / 32) + (c >> 5)) * 512 + ((kk & 7) * 32 + (c & 31)) * 2; }
__device__ __forceinline__ int v_rd_base(int lane) { return ((lane & 3) << 3) | (((lane >> 2) & 3) << 6) | (((lane >> 4) & 1) << 5) | (((lane >> 5) & 1) << 8); }
template <int DV> constexpr int v_rd_off(int d0, int ks, int half) { return d0 * 512 + ks * (2 * (DV / 32) * 512) + half * ((DV / 32) * 512); }
template <int OFF> __device__ __forceinline__ s16x4 tr_read(int vb) {
  s16x4 r; asm volatile("ds_read_b64_tr_b16 %0, %1 offset:%2" : "=&v"(r) : "v"(vb), "i"(OFF) : "memory"); return r;
}
template <int D0, int DV> __device__ __forceinline__ void pv_one(f32x16& od, int vb, bf16x8 pa0, bf16x8 pa1, bf16x8 pa2, bf16x8 pa3) {
  const s16x4 l0 = tr_read<v_rd_off<DV>(D0, 0, 0)>(vb), h0 = tr_read<v_rd_off<DV>(D0, 0, 1)>(vb), l1 = tr_read<v_rd_off<DV>(D0, 1, 0)>(vb), h1 = tr_read<v_rd_off<DV>(D0, 1, 1)>(vb);
  const s16x4 l2 = tr_read<v_rd_off<DV>(D0, 2, 0)>(vb), h2 = tr_read<v_rd_off<DV>(D0, 2, 1)>(vb), l3 = tr_read<v_rd_off<DV>(D0, 3, 0)>(vb), h3 = tr_read<v_rd_off<DV>(D0, 3, 1)>(vb);
  asm volatile("s_waitcnt lgkmcnt(0)" ::: "memory"); SBAR();
#define PK(L, H) (bf16x8){L[0], L[1], L[2], L[3], H[0], H[1], H[2], H[3]}
  od = __builtin_amdgcn_mfma_f32_32x32x16_bf16(pa0, PK(l0, h0), od, 0, 0, 0);
  od = __builtin_amdgcn_mfma_f32_32x32x16_bf16(pa1, PK(l1, h1), od, 0, 0, 0);
  od = __builtin_amdgcn_mfma_f32_32x32x16_bf16(pa2, PK(l2, h2), od, 0, 0, 0);
  od = __builtin_amdgcn_mfma_f32_32x32x16_bf16(pa3, PK(l3, h3), od, 0, 0, 0);
#undef PK
}
template <int DV> __device__ __forceinline__ void pv_all(f32x16* o, int vb, bf16x8 pa0, bf16x8 pa1, bf16x8 pa2, bf16x8 pa3) {
  pv_one<0, DV>(o[0], vb, pa0, pa1, pa2, pa3); pv_one<1, DV>(o[1], vb, pa0, pa1, pa2, pa3);
  if constexpr (DV == 128) { pv_one<2, DV>(o[2], vb, pa0, pa1, pa2, pa3); pv_one<3, DV>(o[3], vb, pa0, pa1, pa2, pa3); }
}
__device__ __forceinline__ void nb_mask(f32x16& p0, f32x16& p1, bool rowok, int tbase, int cs, int hi, const float* T) {
#pragma unroll
  for (int r = 0; r < 16; ++r) { const int kc = crow(r, hi);
    const bool in0 = rowok && kc >= cs && kc < cs + 16; const float b0 = T[tbase + kc]; p0[r] = in0 ? p0[r] + b0 : -1e30f;
    const int kc1 = kc + 32;
    const bool in1 = rowok && kc1 >= cs && kc1 < cs + 16; const float b1 = T[tbase + kc1]; p1[r] = in1 ? p1[r] + b1 : -1e30f; }
}

template <int DK, int DV> constexpr int attn_lds_bytes() { return 2 * 64 * DV * 2 + 2 * 64 * DK * 2 + 2048 + 15 * 128 * 4; }

template <int DK, int DV, int MODE, int SD, int LDQ, int LDK1, int LDK2, int LDV, int LDO>
__device__ __forceinline__ void attn_unit(const AUnit& u, char* lds) {
  constexpr int KBYT = 64 * DK * 2, VBYT = 64 * DV * 2, ND = DK / 16, NO = DV / 32;
  constexpr int OFF_WS = 2 * VBYT + 2 * KBYT, OFF_T = OFF_WS + 2048, OFF_Q = OFF_T + 15 * 128 * 4, NDR = ND > 8 ? 8 : ND;
  constexpr int NLD = (DK == 192 ? 3 : (DK == 128 ? 2 : 1)) + (DV == 128 ? 2 : 1);
  int tid_ = threadIdx.x; asm volatile("" : "+v"(tid_)); const int tid = tid_, wid = __builtin_amdgcn_readfirstlane(tid >> 6), lane = tid & 63, r32 = lane & 31, hi = lane >> 5;
  char* V_lds = lds; char* K_lds = lds + 2 * VBYT;
  float* wsf = (float*)(lds + OFF_WS) + wid * 64; float* li_l = wsf; float* al_l = wsf + 32;
  float* T = (float*)(lds + OFF_T);
  __syncthreads();
  int qrow = 0, qcol = 0, r0w = 0, cs = 0;
  if constexpr (MODE == 1) {
    if (u.nt > u.nctx) { for (int e = tid; e < 15 * 128; e += 512) { const int ro = e >> 7, d = (e & 127) - 64; T[e] = (d >= -15 && d <= 15) ? 8.0f * u.rpb[ro * 31 + d + 15] : 0.f; } }
    qrow = u.R0 + (wid >> 1); qcol = (wid & 1) * 32 + r32;
    r0w = qrow - 4; r0w = r0w < 0 ? 0 : (r0w > 56 ? 56 : r0w);
    cs = qcol - 8; cs = cs < 0 ? 0 : (cs > 48 ? 48 : cs);
  }
  const float C = u.C, thr = 8.0f * 1.4426950408889634f / C;
  float m_reg = -1e30f, l_reg = 0; f32x16 o[NO] = {}; bf16x8 qr[NDR];
  char* qlds = lds + OFF_Q + wid * 4096 + lane * 16;
  const bf16_t* Qw = u.q + (unsigned)((wid * 32 + r32) * LDQ + hi * 8);
#pragma unroll
  for (int d0 = 0; d0 < NDR; ++d0) qr[d0] = ld8(Qw + d0 * 16);
  if constexpr (DK == 192) {
#pragma unroll
    for (int d0 = 0; d0 < 4; ++d0) *reinterpret_cast<bf16x8*>(qlds + d0 * 1024) = ld8(Qw + (8 + d0) * 16); }
  const int sr = tid >> 4, sc = (tid & 15) * 8, sr6 = tid >> 3, sc6 = (tid & 7) * 8;
  const unsigned kof = (DK >= 128 ? (unsigned)(sr * LDK1 + sc) : (unsigned)(sr6 * LDK1 + sc6)) * 2u, k2of = (unsigned)(sr6 * LDK2 + sc6) * 2u, vof = (DV == 128 ? (unsigned)(sr * LDV + sc) : (unsigned)(sr6 * LDV + sc6)) * 2u;
  const int vb0 = (int)(uintptr_t)V_lds + v_rd_base(lane);
  struct { bf16x8 k0, k1, k2, v0, v1; } st[SD];
#define TILEP(bc, bl, ld, j) ((const char*)((j) < u.nctx ? (bc) + (long)(j) * 64 * (ld) : (bl) + (long)((j) - u.nctx) * 64 * (ld)))
#define LDB(base, off) (*reinterpret_cast<const bf16x8*>((base) + (off)))
#define SLOAD(i, j) do { const char* kp_ = TILEP(u.k1c, u.k1l, LDK1, j); const char* vp_ = TILEP(u.vc, u.vl, LDV, j); \
    if constexpr (DK >= 128) { st[i].k0 = LDB(kp_, kof); st[i].k1 = LDB(kp_ + 32 * LDK1 * 2, kof); } \
    if constexpr (DK == 192) { const char* k2_ = TILEP(u.k2c, u.k2l, LDK2, j); st[i].k2 = LDB(k2_, k2of); } \
    if constexpr (DK == 64) { st[i].k0 = LDB(kp_, kof); } \
    if constexpr (DV == 128) { st[i].v0 = LDB(vp_, vof); st[i].v1 = LDB(vp_ + 32 * LDV * 2, vof); } \
    else { st[i].v0 = LDB(vp_, vof); } } while (0)
#define SWRITE(b, i) do { \
    if constexpr (DV == 128) { *(bf16x8*)(V_lds + (b) * VBYT + v_st<DV>(sr, sc)) = st[i].v0; *(bf16x8*)(V_lds + (b) * VBYT + v_st<DV>(32 + sr, sc)) = st[i].v1; } \
    else { *(bf16x8*)(V_lds + (b) * VBYT + v_st<DV>(sr6, sc6)) = st[i].v0; } \
    if constexpr (DK >= 128) { *(bf16x8*)(K_lds + (b) * KBYT + kswz<DK>(sr, sc * 2)) = st[i].k0; *(bf16x8*)(K_lds + (b) * KBYT + kswz<DK>(32 + sr, sc * 2)) = st[i].k1; } \
    if constexpr (DK == 192) { *(bf16x8*)(K_lds + (b) * KBYT + kswz<DK>(sr6, 256 + sc6 * 2)) = st[i].k2; } \
    if constexpr (DK == 64) { *(bf16x8*)(K_lds + (b) * KBYT + kswz<DK>(sr6, sc6 * 2)) = st[i].k0; } } while (0)
#define SWAIT() do { if constexpr (SD == 2 && NLD == 4) asm volatile("s_waitcnt vmcnt(4)" ::: "memory"); else if constexpr (SD == 2 && NLD == 2) asm volatile("s_waitcnt vmcnt(2)" ::: "memory"); \
    else asm volatile("s_waitcnt vmcnt(0)" ::: "memory"); } while (0)
#define RESC(a) do { if (__any((a) < 1.f)) { if (hi == 0) al_l[r32] = (a); asm volatile("s_waitcnt lgkmcnt(0)" ::: "memory"); \
    _Pragma("unroll") for (int d = 0; d < NO; ++d) _Pragma("unroll") for (int r = 0; r < 16; ++r) o[d][r] *= al_l[crow(r, hi)]; } } while (0)
#define MASK(P0, P1, j) do { if constexpr (MODE == 1) { if ((j) >= u.nctx) { const int krow_ = u.klo + (j) - u.nctx; const bool rowok_ = krow_ >= r0w && krow_ < r0w + 8; \
    int dr_ = krow_ - qrow + 7; dr_ = dr_ < 0 ? 0 : (dr_ > 14 ? 14 : dr_); nb_mask(P0, P1, rowok_, dr_ * 128 + 64 - qcol, cs, hi, T); } } } while (0)
  f32x16 pA0, pA1, pB0, pB1; float mnA, mnB, alA, alB; bf16x8 pa0, pa1, pa2, pa3; const int NT = u.nt;
  constexpr int SE = 0, SO = SD - 1;
  SLOAD(SE, 0); asm volatile("s_waitcnt vmcnt(0)" ::: "memory"); SWRITE(0, SE); __syncthreads();
  qkt<DK>(pA0, pA1, K_lds, qr, qlds, r32, hi); MASK(pA0, pA1, 0); partialSM(pA0, pA1, m_reg, mnA, alA, C, thr);
  SLOAD(SO, 1); if constexpr (SD == 2) { if (2 < NT) SLOAD(SE, 2); }
  SWAIT(); SWRITE(1, SO); __syncthreads();
  for (int j = 1; j + 1 < NT; j += 2) {
    SBAR(); qkt<DK>(pB0, pB1, K_lds + KBYT, qr, qlds, r32, hi); MASK(pB0, pB1, j);
    finishSM(pA0, pA1, alA, l_reg, pa0, pa1, pa2, pa3); SBAR();
    SLOAD(SO, j + SD); SBAR();
    pv_all<DV>(o, vb0, pa0, pa1, pa2, pa3); partialSM(pB0, pB1, m_reg, mnB, alB, C, thr);
    __syncthreads(); SWAIT(); SWRITE(0, SE);
    RESC(alB); __syncthreads();
    SBAR(); qkt<DK>(pA0, pA1, K_lds, qr, qlds, r32, hi); MASK(pA0, pA1, j + 1);
    finishSM(pB0, pB1, alB, l_reg, pa0, pa1, pa2, pa3); SBAR();
    if (SD == 1 || j + 3 < NT) SLOAD(SE, j + 1 + SD); SBAR();
    pv_all<DV>(o, vb0 + VBYT, pa0, pa1, pa2, pa3); partialSM(pA0, pA1, m_reg, mnA, alA, C, thr);
    __syncthreads(); SWAIT(); SWRITE(1, SO);
    RESC(alA); __syncthreads();
  }
  SBAR(); qkt<DK>(pB0, pB1, K_lds + KBYT, qr, qlds, r32, hi); MASK(pB0, pB1, NT - 1);
  finishSM(pA0, pA1, alA, l_reg, pa0, pa1, pa2, pa3); SBAR();
  pv_all<DV>(o, vb0, pa0, pa1, pa2, pa3); partialSM(pB0, pB1, m_reg, mnB, alB, C, thr);
  __syncthreads(); RESC(alB);
  finishSM(pB0, pB1, alB, l_reg, pa0, pa1, pa2, pa3); SBAR();
  pv_all<DV>(o, vb0 + VBYT, pa0, pa1, pa2, pa3);
  if (hi == 0) li_l[r32] = l_reg; asm volatile("s_waitcnt lgkmcnt(0)" ::: "memory");
  float rli[16];
#pragma unroll
  for (int r = 0; r < 16; ++r) rli[r] = __builtin_amdgcn_rcpf(li_l[crow(r, hi)]);
  bf16_t* Ow = u.o + (long)(wid * 32) * LDO;
#pragma unroll
  for (int r = 0; r < 16; ++r) { const int orow = crow(r, hi);
#pragma unroll
    for (int d0 = 0; d0 < NO; ++d0) Ow[orow * LDO + d0 * 32 + r32] = f2bf1(o[d0][r] * rli[r]); }
#undef TILEP
#undef LDB
#undef SLOAD
#undef SWRITE
#undef SWAIT
#undef RESC
#undef MASK
}
#undef SBAR
}
#ifndef EN
#define EN 127
#endif
#ifndef AEN
#define AEN 7
#endif
#ifndef REP_ATTN
#define REP_ATTN 1
#endif
#ifndef REP_UP
#define REP_UP 1
#endif
#ifndef REP_NORM
#define REP_NORM 1
#endif
#ifndef REP_PLAIN
#define REP_PLAIN 1
#endif

#define LAS __attribute__((address_space(3)))
typedef float f32x4 __attribute__((ext_vector_type(4)));
typedef unsigned u32x4v __attribute__((ext_vector_type(4)));
typedef unsigned u32x2v __attribute__((ext_vector_type(2)));

__device__ __forceinline__ unsigned f2bf(float f) { unsigned u = __builtin_bit_cast(unsigned, f); return (u + 0x7fffu + ((u >> 16) & 1u)) >> 16; }
__device__ __forceinline__ unsigned pk2(float lo, float hi) { return f2bf(lo) | (f2bf(hi) << 16); }
__device__ __forceinline__ float bf2f(unsigned short b) { return __builtin_bit_cast(float, (unsigned)b << 16); }
__device__ __forceinline__ float bflo(unsigned w) { return __builtin_bit_cast(float, w << 16); }
__device__ __forceinline__ float bfhi(unsigned w) { return __builtin_bit_cast(float, w & 0xffff0000u); }
__device__ __forceinline__ float wave_sum(float v) {
#pragma unroll
    for (int o = 1; o < 64; o <<= 1) v += __shfl_xor(v, o);
    return v;
}
#define LDS_WAIT() asm volatile("s_waitcnt lgkmcnt(0)" ::: "memory")

__device__ __forceinline__ void transpose_item(const float* W, int K, int N, bf16_t* WT, int mode, LAS float* scr, int item, int lane) {
    const int nblk = N / 32, kb = item / nblk, nb = item % nblk, k0 = 64 * kb, n0 = 32 * nb;
    int drow0 = n0;
    if (mode == 1) drow0 = n0 < DFF ? ((n0 >> 7) * 256 + (n0 & 127)) : (((n0 - DFF) >> 7) * 256 + 128 + ((n0 - DFF) & 127));
#pragma unroll 8
    for (int i = 0; i < 32; ++i) { const int kk = 2 * i + (lane >> 5); scr[kk * 33 + (lane & 31)] = W[(size_t)(k0 + kk) * N + n0 + (lane & 31)]; }
    LDS_WAIT(); asm volatile("" ::: "memory");
    const int c = lane & 7;
#pragma unroll
    for (int j = 0; j < 4; ++j) { const int n = (lane >> 3) + 8 * j; const LAS float* s = scr + (8 * c) * 33 + n;
        u32x4v o; o.x = pk2(s[0 * 33], s[1 * 33]); o.y = pk2(s[2 * 33], s[3 * 33]); o.z = pk2(s[4 * 33], s[5 * 33]); o.w = pk2(s[6 * 33], s[7 * 33]);
        *(u32x4v*)(WT + (size_t)(drow0 + n) * K + k0 + 8 * c) = o; }
    LDS_WAIT(); asm volatile("" ::: "memory");
}
__device__ __forceinline__ void cvt_job(const KP& p, bf16_t* Wb, int job, const float*& src, int& K, int& N, bf16_t*& dst, int& mode) {
    mode = 0;
    if (job < 16) { const int l = job >> 2, t = job & 3; bf16_t* lb = Wb + (size_t)l * W_LAYER;
        if (t == 0)      { src = p.in[7]  + (size_t)l * 1024 * 5632; K = 1024; N = 5632; dst = lb + W_13A; mode = 1; }
        else if (t == 1) { src = p.in[8]  + (size_t)l * 2816 * 1024; K = 2816; N = 1024; dst = lb + W_2A; }
        else if (t == 2) { src = p.in[9]  + (size_t)l * 1024 * 5632; K = 1024; N = 5632; dst = lb + W_13B; mode = 1; }
        else             { src = p.in[10] + (size_t)l * 2816 * 1024; K = 2816; N = 1024; dst = lb + W_2B; }
    } else if (job < 24) { const int a = job - 16, j = a >> 2, t = a & 3; bf16_t* mb = Wb + W_MX + (size_t)j * W_ASZ;
        if (t == 0)      { src = p.in[11] + (size_t)j * 1024 * 704;  K = 1024; N = 704;  dst = mb + W_A_IN; }
        else if (t == 1) { src = p.in[14] + (size_t)j * 384 * 1536;  K = 384;  N = 1536; dst = mb + W_A_UQ; }
        else if (t == 2) { src = p.in[15] + (size_t)j * 256 * 2048;  K = 256;  N = 2048; dst = mb + W_A_UKV; }
        else             { src = p.in[16] + (size_t)j * 1024 * 1024; K = 1024; N = 1024; dst = mb + W_A_O; }
    } else if (job == 24) { src = p.in[17]; K = 1024; N = 1536; dst = Wb + W_MXB + W_B_QKV; }
    else if (job == 25)   { src = p.in[20]; K = 1024; N = 1024; dst = Wb + W_MXB + W_B_O; }
    else if (job == 26)   { src = p.in[21]; K = 1024; N = 3072; dst = Wb + W_MXC + W_C_QKV; }
    else                  { src = p.in[23]; K = 1024; N = 1024; dst = Wb + W_MXC + W_C_O; }
}
__device__ __forceinline__ void gemv9_item(LAS float* sv, LAS float* red, const float* W, int ldw, int N, int n0, const float* bias, float* out, int ldo, int tid) {
    const int cg4 = tid & 31, ks = tid >> 5;
    const bool cv = n0 + cg4 * 4 < N;
    const float* wp = W + (size_t)(ks * 64) * ldw + n0 + cg4 * 4;
    f32x4 acc[9];
#pragma unroll
    for (int j = 0; j < 9; ++j) acc[j] = (f32x4){0.f, 0.f, 0.f, 0.f};
    if (cv) {
#pragma unroll 4
        for (int k = 0; k < 64; ++k) { const f32x4 w = *(const f32x4*)(wp + (size_t)k * ldw);
#pragma unroll
            for (int j = 0; j < 9; ++j) acc[j] += w * sv[j * 1024 + ks * 64 + k]; }
    }
#pragma unroll
    for (int j = 0; j < 9; ++j) *(LAS f32x4*)(red + (ks * 9 + j) * 128 + cg4 * 4) = acc[j];
    __syncthreads();
    for (int e = tid; e < 9 * 128; e += 512) { const int j = e >> 7, cidx = e & 127;
        if (n0 + cidx < N) { float s = bias ? bias[n0 + cidx] : 0.f;
#pragma unroll
            for (int q = 0; q < 16; ++q) s += red[(q * 9 + j) * 128 + cidx];
            out[(size_t)j * ldo + n0 + cidx] = s; } }
    __syncthreads();
}
__device__ __forceinline__ void prologue_phase(const KP& p, LAS unsigned char* lds, int tid, int lane, int wave, int G) {
    bf16_t* Wb = (bf16_t*)(p.ws + WS_W);
    {
        LAS float* sv = (LAS float*)lds;
        LAS float* red = (LAS float*)(lds + 40960);
        const float* c = p.in[1]; const float* cc = p.in[3];
        for (int e = tid; e < 9 * 1024; e += 512) { const float x = e < 8192 ? c[e] : cc[e - 8192]; sv[e] = x / (1.0f + __expf(-x)); }
        __syncthreads();
        float* MOD = (float*)(p.ws + WS_MOD);
        for (int item = blockIdx.x; item < 288; item += G) {
            const int colg = item * 128, l = colg / 9216, n0 = colg % 9216;
            gemv9_item(sv, red, p.in[5] + (size_t)l * 1024 * 9216, 9216, 9216, n0, p.in[6] + (size_t)l * 9216, MOD + (size_t)l * 9 * 9216, 9216, tid);
        }
        float* SS = (float*)(p.ws + WS_SS);
        for (int e = blockIdx.x * 512 + tid; e < 12 * MT / 4; e += G * 512) *(f32x4*)(SS + (size_t)e * 4) = (f32x4){0.f, 0.f, 0.f, 0.f};
    }
    __syncthreads();
    {
        LAS float* scr = (LAS float*)(lds + wave * 16384);
        const int gw = blockIdx.x * 8 + wave, NGW = G * 8;
        int base = 0;
        for (int job = 0; job < 28; ++job) {
            const float* src; int K, N, mode; bf16_t* dst;
            cvt_job(p, Wb, job, src, K, N, dst, mode);
            const int nitems = (K / 64) * (N / 32);
            int first = gw - base; if (first < 0) first += NGW;
            for (int it = first; it < nitems; it += NGW) transpose_item(src, K, N, dst, mode, scr, it, lane);
            base = (base + nitems) % NGW;
        }
        for (int e = blockIdx.x * 512 + tid; e < 2 * 64 * 1024 / 8; e += G * 512) { const int j = e / 8192, r = e % 8192;
            *(u32x4v*)(Wb + W_MX + (size_t)j * W_ASZ + W_A_IN + (size_t)704 * 1024 + (size_t)r * 8) = (u32x4v){0u, 0u, 0u, 0u}; }
    }
}

__device__ __forceinline__ void pre_phase(const KP& p, LAS unsigned char* lds, int tid, int lane, int wave, int G) {
    const float* MOD = (const float*)(p.ws + WS_MOD);
    {
        LAS float* sv = (LAS float*)lds; LAS float* red = (LAS float*)(lds + 40960);
        float* SWUP = (float*)(p.ws + WS_SWUP); float* SWPR = (float*)(p.ws + WS_SWPR);
        for (int it = blockIdx.x; it < 400; it += G) {
            const float* W; int ldw, N, n0, l, chunk; float* out; int ldo;
            if (it < 352) { const int job = it / 44; l = job >> 1; const int half = job & 1; W = p.in[half ? 9 : 7] + (size_t)l * 1024 * 5632; ldw = 5632; N = 5632; n0 = (it % 44) * 128; chunk = half ? 6 : 0; out = SWUP + (size_t)job * 9 * 5632; ldo = 5632; }
            else { int r = it - 352; chunk = 3; ldo = 3072;
                if (r < 6) { l = 0; W = p.in[11]; N = 704; }
                else if (r < 18) { r -= 6; l = 1; W = p.in[17]; N = 1536; }
                else if (r < 42) { r -= 18; l = 2; W = p.in[21]; N = 3072; }
                else { r -= 42; l = 3; W = p.in[11] + (size_t)1024 * 704; N = 704; }
                ldw = N; n0 = r * 128; out = SWPR + (size_t)l * 9 * 3072; }
            for (int e = tid; e < 9 * 1024; e += 512) sv[e] = MOD[((size_t)l * 9 + (e >> 10)) * 9216 + chunk * 1024 + (e & 1023)];
            __syncthreads();
            gemv9_item(sv, red, W, ldw, N, n0, nullptr, out, ldo, tid);
        }
    }
    { float* GM = (float*)(p.ws + WS_GM);
      for (int e = blockIdx.x * 512 + tid; e < 12 * 9 * 1024; e += G * 512) { const int col = e & 1023, mb = (e >> 10) % 9, lw = (e >> 10) / 9, l = lw / 3, w = lw % 3;
          GM[e] = p.in[4][(size_t)lw * 1024 + col] * (1.0f + MOD[((size_t)l * 9 + mb) * 9216 + (3 * w + 1) * 1024 + col]); } }
    { const int gw = blockIdx.x * 8 + wave, NGW = G * 8; bf16_t* XN = (bf16_t*)(p.ws + WS_XN); float* SS = (float*)(p.ws + WS_SS);
      const float* g = p.in[4];
      for (int row = gw; row < MT; row += NGW) {
          const int mb = row < ML ? (row >> 12) : 8;
          const float* xr = row < ML ? p.in[0] + (size_t)row * DM : p.in[2] + (size_t)(row - ML) * DM;
          const float* sc = MOD + (size_t)mb * 9216 + 1024;
          float ss = 0.f;
#pragma unroll
          for (int j = 0; j < 4; ++j) { const int col = (lane + 64 * j) * 4; const f32x4 v = *(const f32x4*)(xr + col);
              ss += (v.x * v.x + v.y * v.y) + (v.z * v.z + v.w * v.w);
              const f32x4 y = v * (*(const f32x4*)(g + col)) * (*(const f32x4*)(sc + col) + 1.0f);
              u32x2v w; w.x = pk2(y.x, y.y); w.y = pk2(y.z, y.w);
              *(u32x2v*)(XN + (size_t)row * DM + col) = w; }
          ss = wave_sum(ss);
          if (lane == 0) SS[row] = ss;
      } }
}

__device__ __forceinline__ void norm_phase(const float* xL, const float* xC, const float* g, const float* shift, const float* scale, bf16_t* XN, int gw, int NGW, int lane) {
    for (int row = gw; row < MT; row += NGW) {
        const int mb = row < ML ? (row >> 12) : 8;
        const float* xr = row < ML ? xL + (size_t)row * DM : xC + (size_t)(row - ML) * DM;
        f32x4 v[4]; float ss = 0.f;
#pragma unroll
        for (int j = 0; j < 4; ++j) { v[j] = *(const f32x4*)(xr + (lane + 64 * j) * 4); ss += (v[j].x * v[j].x + v[j].y * v[j].y) + (v[j].z * v[j].z + v[j].w * v[j].w); }
        const float rstd = __builtin_amdgcn_rsqf(wave_sum(ss) * (1.0f / DM) + EPS);
        const float* sh = shift + (size_t)mb * 9216; const float* sc = scale + (size_t)mb * 9216;
#pragma unroll
        for (int j = 0; j < 4; ++j) { const int col = (lane + 64 * j) * 4;
            const f32x4 gg = *(const f32x4*)(g + col), s1 = *(const f32x4*)(sc + col), s0 = *(const f32x4*)(sh + col);
            const f32x4 y = (v[j] * rstd) * gg * (s1 + 1.0f) + s0;
            u32x2v w; w.x = pk2(y.x, y.y); w.y = pk2(y.z, y.w);
            *(u32x2v*)(XN + (size_t)row * DM + col) = w; }
    }
}
__device__ __forceinline__ void final_norm_phase(float* x, const float* g, int gw, int NGW, int lane) {
    for (int row = gw; row < ML; row += NGW) {
        float* xr = x + (size_t)row * DM;
        f32x4 v[4]; float ss = 0.f;
#pragma unroll
        for (int j = 0; j < 4; ++j) { v[j] = *(const f32x4*)(xr + (lane + 64 * j) * 4); ss += (v[j].x * v[j].x + v[j].y * v[j].y) + (v[j].z * v[j].z + v[j].w * v[j].w); }
        const float rstd = __builtin_amdgcn_rsqf(wave_sum(ss) * (1.0f / DM) + EPS);
#pragma unroll
        for (int j = 0; j < 4; ++j) { const int col = (lane + 64 * j) * 4; const f32x4 gg = *(const f32x4*)(g + col);
            *(f32x4*)(xr + col) = (v[j] * rstd) * gg; }
    }
}
__device__ __forceinline__ void mla_norm_phase(const bf16_t* PROJ, const float* gq, const float* gkv, bf16_t* CQN, bf16_t* CKVN, bf16_t* KR, int gw, int NGW, int lane) {
    const int pidx = lane & 31;
    const float invf = __builtin_amdgcn_exp2f(-(float)(pidx & 15) * (LOG2_THETA / 16.0f));
    for (int row = gw; row < MT; row += NGW) {
        const bf16_t* pr = PROJ + (size_t)row * 768;
        unsigned q[3]; float ss = 0.f;
#pragma unroll
        for (int i = 0; i < 3; ++i) { q[i] = *(const unsigned*)(pr + lane * 2 + 128 * i); const float a = bflo(q[i]), b = bfhi(q[i]); ss += a * a + b * b; }
        const u32x2v kv = *(const u32x2v*)(pr + 384 + lane * 4);
        const float k0 = bflo(kv.x), k1 = bfhi(kv.x), k2 = bflo(kv.y), k3 = bfhi(kv.y);
        float s2 = (k0 * k0 + k1 * k1) + (k2 * k2 + k3 * k3);
        const float xr = bf2f(pr[640 + lane]);
        const float rq = __builtin_amdgcn_rsqf(wave_sum(ss) * (1.0f / 384.0f) + EPS);
        const float rkv = __builtin_amdgcn_rsqf(wave_sum(s2) * (1.0f / 256.0f) + EPS);
#pragma unroll
        for (int i = 0; i < 3; ++i) { const int col = lane * 2 + 128 * i;
            *(unsigned*)(CQN + (size_t)row * 384 + col) = pk2(bflo(q[i]) * rq * gq[col], bfhi(q[i]) * rq * gq[col + 1]); }
        { const int col = lane * 4; const f32x4 gg = *(const f32x4*)(gkv + col);
          u32x2v w; w.x = pk2(k0 * rkv * gg.x, k1 * rkv * gg.y); w.y = pk2(k2 * rkv * gg.z, k3 * rkv * gg.w);
          *(u32x2v*)(CKVN + (size_t)row * 256 + col) = w; }
        float outv = xr;
        const float other = __shfl_xor(xr, 32);
        if (row < ML) { const int t = row & 4095; const float pos = (float)(pidx < 16 ? (t >> 6) : (t & 63)); const float ang = pos * invf;
            const float cs = __cosf(ang), sn = __sinf(ang);
            outv = lane < 32 ? (xr * cs - other * sn) : (xr * cs + other * sn); }
        KR[(size_t)row * 64 + lane] = (bf16_t)f2bf(outv);
    }
}
__device__ __forceinline__ void mla_qrope_phase(bf16_t* Q, int gw, int NGW, int lane) {
    const int head = lane >> 3, sub = lane & 7;
    float invf[4];
#pragma unroll
    for (int i = 0; i < 4; ++i) invf[i] = __builtin_amdgcn_exp2f(-(float)((sub * 4 + i) & 15) * (LOG2_THETA / 16.0f));
    for (int row = gw; row < ML; row += NGW) {
        bf16_t* qp = Q + (size_t)row * 1536 + head * 192 + 128 + sub * 4;
        const u32x2v a = *(const u32x2v*)qp, b = *(const u32x2v*)(qp + 32);
        const float x1[4] = {bflo(a.x), bfhi(a.x), bflo(a.y), bfhi(a.y)}, x2[4] = {bflo(b.x), bfhi(b.x), bflo(b.y), bfhi(b.y)};
        const int t = row & 4095; const float pos = (float)(sub < 4 ? (t >> 6) : (t & 63));
        float o1[4], o2[4];
#pragma unroll
        for (int i = 0; i < 4; ++i) { const float ang = pos * invf[i]; const float cs = __cosf(ang), sn = __sinf(ang);
            o1[i] = x1[i] * cs - x2[i] * sn; o2[i] = x2[i] * cs + x1[i] * sn; }
        u32x2v w1, w2; w1.x = pk2(o1[0], o1[1]); w1.y = pk2(o1[2], o1[3]); w2.x = pk2(o2[0], o2[1]); w2.y = pk2(o2[2], o2[3]);
        *(u32x2v*)qp = w1; *(u32x2v*)(qp + 32) = w2;
    }
}
__device__ __forceinline__ void gqa_normrope_phase(bf16_t* PROJ, const float* gq, const float* gk, int gw, int NGW, int lane) {
    const float invf = __builtin_amdgcn_exp2f(-(float)(lane & 31) * (LOG2_THETA / 32.0f));
    for (int row = gw; row < MT; row += NGW) {
        bf16_t* pr = PROJ + (size_t)row * 1536;
        const bool lat = row < ML; const int t = row & 4095; const float pos = (float)(lane < 32 ? (t >> 6) : (t & 63));
        const float ang = pos * invf; const float cs = lat ? __cosf(ang) : 1.0f, sn = lat ? __sinf(ang) : 0.0f;
#pragma unroll 2
        for (int hh = 0; hh < 10; ++hh) {
            bf16_t* hp = pr + hh * 128; const float* g = hh < 8 ? gq : gk;
            const float x1 = bf2f(hp[lane]), x2 = bf2f(hp[64 + lane]);
            const float rstd = __builtin_amdgcn_rsqf(wave_sum(x1 * x1 + x2 * x2) * (1.0f / 128.0f) + EPS);
            const float y1 = x1 * rstd * g[lane], y2 = x2 * rstd * g[64 + lane];
            hp[lane] = (bf16_t)f2bf(y1 * cs - y2 * sn); hp[64 + lane] = (bf16_t)f2bf(y2 * cs + y1 * sn);
        }
    }
}

__device__ __forceinline__ void attn_phase(int kind, const KP& p, int jm, char* lds, int G) {
    unsigned char* ws = p.ws; bf16_t* XN = (bf16_t*)(ws + WS_XN);
    const int bid = blockIdx.x;
#if AEN & 1
    if (kind == 0) {
        const bf16_t* Q = (const bf16_t*)(ws + WS_TMP + T_AQ); const bf16_t* KV = (const bf16_t*)(ws + WS_TMP + T_AKV); const bf16_t* KR = (const bf16_t*)(ws + WS_TMP + T_AKR);
        const int nlat = 1024, ntot = nlat + 64;
        for (int uidx = bid; uidx < ntot; uidx += G) {
            att::AUnit u; int b, h; size_t qrow;
            if (uidx < nlat) { const int rnd = uidx / G, xcd = bid & 7, slot = bid >> 3; const int pair = rnd * 16 + xcd * 2 + (slot >> 4); b = pair >> 3; h = pair & 7; qrow = (size_t)b * SEQ + (size_t)(slot & 15) * 256; u.nt = 68; }
            else { const int c = uidx - nlat; b = c >> 3; h = c & 7; qrow = (size_t)ML + (size_t)b * CTXL; u.nt = 4; }
            const size_t crow0 = (size_t)ML + (size_t)b * CTXL, lrow0 = (size_t)b * SEQ;
            u.q = Q + qrow * 1536 + h * 192;
            u.k1c = KV + crow0 * 2048 + h * 256; u.k1l = KV + lrow0 * 2048 + h * 256;
            u.k2c = KR + crow0 * 64; u.k2l = KR + lrow0 * 64;
            u.vc = u.k1c + 128; u.vl = u.k1l + 128;
            u.o = XN + qrow * 1024 + h * 128; u.nctx = 4; u.C = 0.07216878364870322f * 1.4426950408889634f;
            u.R0 = 0; u.klo = 0; u.rpb = nullptr;
            att::attn_unit<192, 128, 0, 1, 1536, 2048, 64, 2048, 1024>(u, lds);
        }
    }
#endif
#if AEN & 2
    if (kind == 1) {
        const bf16_t* PR = (const bf16_t*)(ws + WS_TMP + T_PROJ);
        const int nlat = 1024, ntot = nlat + 64;
        for (int uidx = bid; uidx < ntot; uidx += G) {
            att::AUnit u; int b, h; size_t qrow;
            if (uidx < nlat) { const int rnd = uidx / G, xcd = bid & 7, slot = bid >> 3; const int pair = rnd * 16 + xcd * 2 + (slot >> 4); b = pair >> 3; h = pair & 7; qrow = (size_t)b * SEQ + (size_t)(slot & 15) * 256; u.nt = 68; }
            else { const int c = uidx - nlat; b = c >> 3; h = c & 7; qrow = (size_t)ML + (size_t)b * CTXL; u.nt = 4; }
            const int kvh = h >> 2;
            const size_t crow0 = (size_t)ML + (size_t)b * CTXL, lrow0 = (size_t)b * SEQ;
            u.q = PR + qrow * 1536 + h * 128;
            u.k1c = PR + crow0 * 1536 + 1024 + kvh * 128; u.k1l = PR + lrow0 * 1536 + 1024 + kvh * 128;
            u.k2c = nullptr; u.k2l = nullptr;
            u.vc = u.k1c + 256; u.vl = u.k1l + 256;
            u.o = XN + qrow * 1024 + h * 128; u.nctx = 4; u.C = 0.08838834764831845f * 1.4426950408889634f;
            u.R0 = 0; u.klo = 0; u.rpb = nullptr;
            att::attn_unit<128, 128, 0, 2, 1536, 1536, 64, 1536, 1024>(u, lds);
        }
    }
#endif
#if AEN & 4
    if (kind == 2) {
        const bf16_t* PR = (const bf16_t*)(ws + WS_TMP + T_PROJ);
        const float* rpb = p.in[22] + (size_t)jm * 16 * 15 * 31;
        const int nlat = 2048, ntot = nlat + 128;
        for (int uidx = bid; uidx < ntot; uidx += G) {
            att::AUnit u; int b, h; size_t qrow; u.R0 = 0; u.klo = 0;
            if (uidx < nlat) { const int rnd = uidx / G, xcd = bid & 7, slot = bid >> 3; const int pair = rnd * 16 + xcd * 2 + (slot >> 4); b = pair >> 4; h = pair & 15;
                const int R0 = (slot & 15) * 4; qrow = (size_t)b * SEQ + (size_t)R0 * 64;
                int klo = R0 - 4; klo = klo < 0 ? 0 : (klo > 56 ? 56 : klo);
                int khi = R0 - 1; khi = khi < 0 ? 0 : (khi > 56 ? 56 : khi); khi += 7;
                if (((khi - klo + 1) & 1) != 0) { if (khi < 63) ++khi; else --klo; }
                u.R0 = R0; u.klo = klo; u.nt = 4 + (khi - klo + 1); }
            else { const int c = uidx - nlat; b = c >> 4; h = c & 15; qrow = (size_t)ML + (size_t)b * CTXL; u.nt = 4; }
            const size_t crow0 = (size_t)ML + (size_t)b * CTXL, lrow0 = (size_t)b * SEQ + (size_t)u.klo * 64;
            u.q = PR + qrow * 3072 + h * 64;
            u.k1c = PR + crow0 * 3072 + 1024 + h * 64; u.k1l = PR + lrow0 * 3072 + 1024 + h * 64;
            u.k2c = nullptr; u.k2l = nullptr;
            u.vc = u.k1c + 1024; u.vl = u.k1l + 1024;
            u.o = XN + qrow * 1024 + h * 64; u.nctx = 4; u.C = 0.125f * 1.4426950408889634f;
            u.rpb = rpb + (size_t)h * 15 * 31;
            att::attn_unit<64, 64, 1, 2, 3072, 3072, 64, 3072, 1024>(u, lds);
        }
    }
#endif
}

enum { T_SKIP = 0, T_NORM, T_UP, T_RES, T_PLAIN, T_ELT_A1, T_ELT_A2, T_ELT_B, T_ATTN };

__global__ void __launch_bounds__(512, 2) fwd_mega(KP p, int ph_lo, int ph_hi) {
    extern __shared__ __attribute__((aligned(16))) unsigned char lds_raw[];
    cg::grid_group grid = cg::this_grid();
    LAS unsigned char* lds = (LAS unsigned char*)lds_raw;
    const int G = gridDim.x, NGW = G * 8;
    unsigned char* ws = p.ws;
    bf16_t* Wb = (bf16_t*)(ws + WS_W); bf16_t* XN = (bf16_t*)(ws + WS_XN); float* XC = (float*)(ws + WS_XC); float* MOD = (float*)(ws + WS_MOD);
    unsigned char* tmp = ws + WS_TMP;
    int phase = 0, repc = 0;
#define SEAM() do { ++phase; if (phase > ph_lo && phase < ph_hi) grid.sync(); } while (0)
#define ACTIVE() (phase >= ph_lo && phase < ph_hi)
#if EN & 64
    if (ACTIVE()) { int tl_ = threadIdx.x; asm volatile("" : "+v"(tl_)); prologue_phase(p, lds, tl_, tl_ & 63, __builtin_amdgcn_readfirstlane(tl_ >> 6), G); }
#endif
    SEAM();
    if (ACTIVE()) { int tl_ = threadIdx.x; asm volatile("" : "+v"(tl_)); pre_phase(p, lds, tl_, tl_ & 63, __builtin_amdgcn_readfirstlane(tl_ >> 6), G); }
    SEAM();
    for (int l = 0; l < DEPTH; ++l) {
        const int kind = l % 3, jm = l / 3;
        const float* modl = MOD + (size_t)l * 9 * 9216;
        bf16_t* WL = Wb + (size_t)l * W_LAYER;
        for (int s = 0; s < 13; ++s) {
            int type;
            switch (s) {
            case 1: case 11: type = T_UP; break;
            case 2: case 9: case 12: type = T_RES; break;
            case 4: type = T_PLAIN; break;
            case 5: type = kind == 0 ? T_ELT_A1 : (kind == 1 ? T_ELT_B : T_SKIP); break;
            case 6: type = kind == 0 ? T_PLAIN : T_SKIP; break;
            case 7: type = kind == 0 ? T_ELT_A2 : T_SKIP; break;
            case 8: type = T_ATTN; break;
            default: type = T_SKIP; break;
            }
            if (type == T_SKIP) continue;
            if (ACTIVE()) {
                int tl_ = threadIdx.x; asm volatile("" : "+v"(tl_)); const int lane = tl_ & 63; const int gw = blockIdx.x * 8 + __builtin_amdgcn_readfirstlane(tl_ >> 6);
                switch (type) {
#if EN & 2
                case T_UP: { const int half = s == 1 ? 0 : 1;
                    pg8::Gemm g{half ? (const bf16_t*)(tmp + T_XG2) : XN, WL + (half ? W_13B : W_13A), MT, 2 * DFF, DM}; pg8::StaticOrder S; S.init(MT, 2 * DFF, G, (int)blockIdx.x, DM, 0);
                    pg8::EpiSwiglu E{l, half};
                    pg8::gemm_phase<pg8::EpiSwiglu, pg8::StaticOrder, true, true>(lds, g, S, E); } break;
#endif
#if EN & 4
                case T_RES: { const bf16_t* gA; const bf16_t* gB; int gK;
                    if (s == 9) { gA = XN; gK = 1024; gB = kind == 0 ? Wb + W_MX + (size_t)jm * W_ASZ + W_A_O : (kind == 1 ? Wb + W_MXB + W_B_O : Wb + W_MXC + W_C_O); }
                    else { gA = (const bf16_t*)(tmp + T_ACT); gK = DFF; gB = WL + (s == 2 ? W_2A : W_2B); }
                    pg8::Gemm g{gA, gB, MT, DM, gK}; pg8::StaticOrder S; S.init(MT, DM, G, (int)blockIdx.x, gK, 0);
                    pg8::EpiRes E{l, s};
                    pg8::gemm_phase<pg8::EpiRes, pg8::StaticOrder, true, true>(lds, g, S, E); } break;
#endif
#if EN & 8
                case T_PLAIN: {
                    const int ngem = s == 6 ? 2 : 1;
                    for (int gi = 0; gi < ngem; ++gi) {
                        const bf16_t* gA; const bf16_t* gB; int gN, gK; bf16_t* gO; int ssidx = -1;
                        if (s == 4) { gA = XN; gK = 1024; ssidx = l * 3 + 1;
                            if (kind == 0)      { gB = Wb + W_MX + (size_t)jm * W_ASZ + W_A_IN; gN = 768; gO = (bf16_t*)(tmp + T_APROJ); }
                            else if (kind == 1) { gB = Wb + W_MXB + W_B_QKV; gN = 1536; gO = (bf16_t*)(tmp + T_PROJ); }
                            else                { gB = Wb + W_MXC + W_C_QKV; gN = 3072; gO = (bf16_t*)(tmp + T_PROJ); } }
                        else if (gi == 0) { gA = (const bf16_t*)(tmp + T_ACQN); gB = Wb + W_MX + (size_t)jm * W_ASZ + W_A_UQ; gN = 1536; gK = 384; gO = (bf16_t*)(tmp + T_AQ); }
                        else { gA = (const bf16_t*)(tmp + T_ACKVN); gB = Wb + W_MX + (size_t)jm * W_ASZ + W_A_UKV; gN = 2048; gK = 256; gO = (bf16_t*)(tmp + T_AKV); }
                        pg8::Gemm g{gA, gB, MT, gN, gK}; pg8::StaticOrder S; S.init(MT, gN, G, (int)blockIdx.x, gK, 0);
                        pg8::EpiBf16N E{gO, gN, ssidx, l};
                        pg8::gemm_phase<pg8::EpiBf16N, pg8::StaticOrder, true, true>(lds, g, S, E);
                        __syncthreads();
                    } } break;
#endif
#if EN & 16
                case T_ELT_A1: mla_norm_phase((const bf16_t*)(tmp + T_APROJ), p.in[12] + (size_t)jm * 384, p.in[13] + (size_t)jm * 256,
                                              (bf16_t*)(tmp + T_ACQN), (bf16_t*)(tmp + T_ACKVN), (bf16_t*)(tmp + T_AKR), gw, NGW, lane); break;
                case T_ELT_A2: mla_qrope_phase((bf16_t*)(tmp + T_AQ), gw, NGW, lane); break;
                case T_ELT_B: gqa_normrope_phase((bf16_t*)(tmp + T_PROJ), p.in[18] + (size_t)jm * 128, p.in[19] + (size_t)jm * 128, gw, NGW, lane); break;
#endif
#if EN & 32
                case T_ATTN: attn_phase(kind, p, jm, (char*)lds_raw, G); break;
#endif
                default: break;
                }
            }
            SEAM();
            { const int nrep_ = (type == T_ATTN) ? REP_ATTN : (type == T_UP) ? REP_UP : (type == T_PLAIN) ? REP_PLAIN : 1;
              if (repc + 1 < nrep_) { ++repc; --s; } else repc = 0; }
        }
    }
    if (ACTIVE()) { int tl_ = threadIdx.x; asm volatile("" : "+v"(tl_)); final_norm_phase(p.out, p.in[24], blockIdx.x * 8 + __builtin_amdgcn_readfirstlane(tl_ >> 6), NGW, tl_ & 63); }
#undef SEAM
#undef ACTIVE
}

extern "C" void kernel_launch(void* const* d_in, const int* in_sizes, int n_in, void* d_out, int out_size, void* d_ws, size_t ws_size, hipStream_t stream) {
    static int grid = 0;
    if (grid == 0) {
        if (n_in != 25 || out_size != ML * DM || ws_size < WS_END) { fprintf(stderr, "kernel_launch: unexpected shapes: n_in %d out %d ws %zu (need %zu)\n", n_in, out_size, ws_size, (size_t)WS_END); grid = -1; return; }
        int dev = 0, cus = 0, per_cu = 0;
        hipGetDevice(&dev); hipDeviceGetAttribute(&cus, hipDeviceAttributeMultiprocessorCount, dev);
        if (hipFuncSetAttribute((const void*)fwd_mega, hipFuncAttributeMaxDynamicSharedMemorySize, LDS_BYTES) != hipSuccess) { fprintf(stderr, "kernel_launch: hipFuncSetAttribute failed\n"); grid = -1; return; }
        if (hipOccupancyMaxActiveBlocksPerMultiprocessor(&per_cu, (const void*)fwd_mega, 512, LDS_BYTES) != hipSuccess || per_cu < 1) { fprintf(stderr, "kernel_launch: occupancy query says %d\n", per_cu); per_cu = 1; }
        (void)hipGetLastError();
        grid = cus;
        fprintf(stderr, "kernel_launch: grid %d (cus %d, per_cu %d)\n", grid, cus, per_cu);
    }
    if (grid < 0) return;
    KP p{};
    for (int i = 0; i < 25; ++i) p.in[i] = (const float*)d_in[i];
    p.out = (float*)d_out; p.ws = (unsigned char*)d_ws;
#ifndef N_LAUNCH_SPLIT
    int lo = 0, hi = 1 << 30;
    void* args[] = {&p, &lo, &hi};
    hipError_t e = hipLaunchCooperativeKernel((const void*)fwd_mega, dim3(grid), dim3(512), args, LDS_BYTES, stream);
    if (e != hipSuccess) fprintf(stderr, "cooperative launch failed: %s (grid %d)\n", hipGetErrorString(e), grid);
#else
    const int nph = 2 + DEPTH * 13;
    for (int ph = 0; ph < nph; ++ph) { int lo = ph, hi = ph + 1; void* args[] = {&p, &lo, &hi};
        hipError_t e = hipLaunchCooperativeKernel((const void*)fwd_mega, dim3(grid), dim3(512), args, LDS_BYTES, stream);
        if (e != hipSuccess) { fprintf(stderr, "launch %d failed: %s\n", ph, hipGetErrorString(e)); break; } }
#endif
}
```

```cpp
#include <hip/hip_runtime.h>
#include <hip/hip_bf16.h>
#include <hip/hip_cooperative_groups.h>
#include <cstdio>
#include <cstdint>
namespace cg = cooperative_groups;
typedef unsigned short bf16_t;
constexpr int DM = 1024, NB = 8, SEQ = 4096, ML = NB * SEQ, CTXL = 256, MC = NB * CTXL, MT = ML + MC, DFF = 2816, DEPTH = 4;
constexpr float EPS = 1e-6f;
constexpr float LOG2_THETA = 13.287712379549449f;
constexpr size_t MiB = 1u << 20;
constexpr size_t WS_MOD = 1 * MiB, WS_SS = 3 * MiB, WS_GM = 5 * MiB, WS_SWUP = 6 * MiB, WS_SWPR = 8 * MiB, WS_XC = 9 * MiB, WS_W = 17 * MiB, WS_XN = 174 * MiB, WS_TMP = 242 * MiB, WS_END = 532 * MiB;
constexpr size_t T_XG2 = 188 * MiB;
constexpr size_t W_LAYER = 17301504, W_13A = 0, W_2A = 5767168, W_13B = 8650752, W_2B = 14417920;
constexpr size_t W_MX = 69206016, W_ASZ = 2949120, W_A_IN = 0, W_A_UQ = 786432, W_A_UKV = 1376256, W_A_O = 1900544;
constexpr size_t W_MXB = W_MX + 2 * W_ASZ, W_B_QKV = 0, W_B_O = 1572864;
constexpr size_t W_MXC = W_MXB + 2621440, W_C_QKV = 0, W_C_O = 3145728;
static_assert(W_MXC + 4194304 == 81920000 && WS_W + 81920000ull * 2 <= WS_XN, "weight map");
constexpr size_t T_ACT = 0;
constexpr size_t T_AQ = 0, T_ACQN = 102 * MiB, T_ACKVN = 128 * MiB, T_AKR = 146 * MiB, T_AKV = 152 * MiB, T_APROJ = 152 * MiB;
constexpr size_t T_PROJ = 0;
static_assert(WS_TMP + T_AKV + (size_t)MT * 2048 * 2 <= WS_END && WS_TMP + (size_t)MT * 3072 * 2 <= WS_END, "tmp map");
constexpr int LDS_BYTES = 147456;

struct KP { const float* in[25]; float* out; unsigned char* ws; };


#define KARGS() ({ const __attribute__((address_space(4))) KP* kp_ = (const __attribute__((address_space(4))) KP*)__builtin_amdgcn_kernarg_segment_ptr(); asm volatile("" : "+s"(kp_)); kp_; })
namespace pg8 {
#define PG8_LAS __attribute__((address_space(3)))
typedef unsigned short bf16_t;
typedef short bf16x8 __attribute__((ext_vector_type(8)));
typedef float f32x4 __attribute__((ext_vector_type(4)));
typedef unsigned u32x4 __attribute__((ext_vector_type(4)));
typedef unsigned u32x2 __attribute__((ext_vector_type(2)));
constexpr int BM = 256, BK = 64, HALF = 128, HTB = HALF * BK * 2  , STAGE_BYTES = 8 * HTB, NXCD = 8, WGM = 8;

__host__ __device__ __forceinline__ int lds_byte(int r, int c) { const int st = (r >> 4) * 2 + (c >> 5), rr = r & 15, cc = c & 31, ob = rr * 64 + cc * 2; return st * 1024 + (ob ^ (((ob >> 9) & 1) << 5)); }
__host__ __device__ __forceinline__ void stage_rc(int b, int& R, int& C) { const int st = b / 1024, sb = b % 1024, swz = sb ^ (((sb >> 9) & 1) << 5); R = (st >> 1) * 16 + swz / 64; C = (st & 1) * 32 + (swz % 64) / 2; }
__host__ __device__ __forceinline__ int perm32(int rho) { const int n = rho >> 4, i = rho & 15; return 8 * (i >> 2) + 4 * n + (i & 3); }

struct Unit { int pm, pn, kt0, nt, part; };
struct Gemm { const bf16_t* A; const bf16_t* Bt; int M, N, K; };

struct StaticOrder {
    int nM, nN, nwg, G, c, ntk, split;
    __host__ __device__ void init(int M, int N, int G_, int c_, int K_ = 0, int split_ = 0) { nM = M / BM; nN = N / BM; nwg = nM * nN; G = G_; c = c_; ntk = K_ / BK; split = split_; }
    __host__ __device__ void map(int wgid, Unit& u) const {
        { const int q = nwg / NXCD, r = nwg % NXCD, xcd = wgid % NXCD, off = wgid / NXCD; wgid = (xcd < r ? xcd * (q + 1) : r * (q + 1) + (xcd - r) * q) + off; }
        const int nig = WGM * nN, gid = wgid / nig, fm = gid * WGM, gsz = (nM - fm) < WGM ? (nM - fm) : WGM;
        u.pm = fm + ((wgid % nig) % gsz); u.pn = (wgid % nig) / gsz;
    }
    __host__ __device__ bool next(int i, Unit& u) const {
        const long L = (long)i * G + c;
        const int nfull = split ? (nwg / G) * G : nwg;
        if (L < nfull) { map((int)L, u); u.kt0 = 0; u.nt = ntk; u.part = 0; return true; }
        if (!split || i != nwg / G) return false;
        const int rem = nwg - nfull, ways = G / rem, j = c / ways, kp = c % ways;
        if (j >= rem) return false;
        const int P = ntk / 2, p0 = kp * P / ways, p1 = (kp + 1) * P / ways;
        if (p1 <= p0) return false;
        map(nfull + j, u); u.kt0 = 2 * p0; u.nt = 2 * (p1 - p0); u.part = 1; return true;
    }
    __device__ __forceinline__ void a_ready(const Unit&) const {}
    __device__ __forceinline__ void done(const Unit&) const {}
};

__device__ __forceinline__ unsigned cvt_pk_bf16(float lo, float hi) { unsigned r; asm volatile("v_cvt_pk_bf16_f32 %0, %1, %2" : "=v"(r) : "v"(lo), "v"(hi)); return r; }
typedef float f32x2 __attribute__((ext_vector_type(2)));
__device__ __forceinline__ f32x2 gelu_pk(f32x2 v) {
    const f32x2 av = __builtin_elementwise_abs(v), d = av * 0.2316418882f + 1.0f;
    f32x2 t; t.x = __builtin_amdgcn_rcpf(d.x); t.y = __builtin_amdgcn_rcpf(d.y);
    f32x2 q = t * 0.5307027145f + (-0.7265760135f); q = q * t + 0.7107068705f; q = q * t + (-0.142248368f); q = q * t + 0.127414796f; q = q * t;
    const f32x2 s = (v * v) * (-0.72134752044f);
    f32x2 e; e.x = __builtin_amdgcn_exp2f(s.x); e.y = __builtin_amdgcn_exp2f(s.y);
    const f32x2 m = v * (q * e), r = v - m;
    f32x2 o; o.x = v.x < 0.f ? m.x : r.x; o.y = v.y < 0.f ? m.y : r.y; return o;
}

template <int ACT  > struct EpiBf16 {
    static constexpr bool PERM = true, AFTER_DRAIN = false; static_assert(ACT == 0 || ACT == 1, "EpiBf16: ACT is 0 (none) or 1 (gelu_pk)");
    bf16_t* O; int ldc; const float* bias; int split_cols; size_t split_stride; float scale0;
    __device__ __forceinline__ void operator()(const f32x4 (&acc)[2][2][4][2], const Unit& u, int wr, int wc, int fr, int fq) const {
        const int row0 = u.pm * BM + wr * 64 + fr; int colt = u.pn * BM; bf16_t* base = O;
        float sc = 1.f; if (split_cols) { const int t = colt / split_cols; base += (size_t)t * split_stride; colt -= t * split_cols; if (t == 0) sc = scale0; }
        const int col0 = colt + wc * 32 + 8 * fq, bcol0 = u.pn * BM + wc * 32 + 8 * fq;
        f32x4 bv[2][2];
#pragma unroll
        for (int bj = 0; bj < 2; ++bj)
#pragma unroll
            for (int n = 0; n < 2; ++n) bv[bj][n] = bias ? *(const f32x4*)(bias + bcol0 + bj * HALF + 4 * n) : (f32x4){0.f, 0.f, 0.f, 0.f};
#pragma unroll
        for (int ai = 0; ai < 2; ++ai)
#pragma unroll
            for (int m = 0; m < 4; ++m) { bf16_t* rowp = base + (size_t)(row0 + ai * HALF + m * 16) * ldc + col0;
#pragma unroll
                for (int bj = 0; bj < 2; ++bj) { f32x4 v0 = acc[ai][bj][m][0] + bv[bj][0], v1 = acc[ai][bj][m][1] + bv[bj][1];
                    if (ACT == 1) { f32x2 a = gelu_pk((f32x2){v0[0], v0[1]}), b = gelu_pk((f32x2){v0[2], v0[3]}), c = gelu_pk((f32x2){v1[0], v1[1]}), d = gelu_pk((f32x2){v1[2], v1[3]});
                        v0 = (f32x4){a.x, a.y, b.x, b.y}; v1 = (f32x4){c.x, c.y, d.x, d.y}; }
                    v0 = v0 * sc; v1 = v1 * sc; u32x4 w; w.x = cvt_pk_bf16(v0[0], v0[1]); w.y = cvt_pk_bf16(v0[2], v0[3]); w.z = cvt_pk_bf16(v1[0], v1[1]); w.w = cvt_pk_bf16(v1[2], v1[3]);
                    *(u32x4*)(rowp + bj * HALF) = w; } }
    }
};

__device__ __forceinline__ float silu_f(float g) { return g * __builtin_amdgcn_rcpf(1.0f + __builtin_amdgcn_exp2f(-1.4426950408889634f * g)); }
constexpr float NEPS = 1e-6f;
struct EpiSwiglu {
    static constexpr bool PERM = true, AFTER_DRAIN = false;
    int l, half;
    __device__ __forceinline__ void operator()(const f32x4 (&acc)[2][2][4][2], const Unit& u, int wr, int wc, int fr, int fq) const {
        const auto kp = KARGS(); unsigned char* ws = kp->ws;
        bf16_t* O = (bf16_t*)(ws + WS_TMP + T_ACT); constexpr int ldc = DFF; const float* SS = (const float*)(ws + WS_SS) + (size_t)(l * 3 + (half ? 2 : 0)) * MT;
        const float* SW = (const float*)(ws + WS_SWUP) + (size_t)(l * 2 + half) * 9 * 5632;
        const int row0 = u.pm * BM + wr * 64 + fr; const int col0 = u.pn * HALF + wc * 32 + 8 * fq;
        const int mb = u.pm < 128 ? (u.pm >> 4) : 8;
        const float* swp = SW + (size_t)mb * 5632 + col0;
        const f32x4 sg0 = *(const f32x4*)swp, sg1 = *(const f32x4*)(swp + 4), su0 = *(const f32x4*)(swp + 2816), su1 = *(const f32x4*)(swp + 2820);
#pragma unroll
        for (int ai = 0; ai < 2; ++ai)
#pragma unroll
            for (int m = 0; m < 4; ++m) { const int row = row0 + ai * HALF + m * 16; bf16_t* rowp = O + (size_t)row * ldc + col0;
                const float rstd = __builtin_amdgcn_rsqf(SS[row] * (1.0f / 1024.0f) + NEPS);
                const f32x4 g0 = acc[ai][0][m][0] * rstd + sg0, g1 = acc[ai][0][m][1] * rstd + sg1, u0 = acc[ai][1][m][0] * rstd + su0, u1 = acc[ai][1][m][1] * rstd + su1;
                f32x4 v0, v1;
#pragma unroll
                for (int i = 0; i < 4; ++i) { v0[i] = silu_f(g0[i]) * u0[i]; v1[i] = silu_f(g1[i]) * u1[i]; }
                u32x4 w; w.x = cvt_pk_bf16(v0[0], v0[1]); w.y = cvt_pk_bf16(v0[2], v0[3]); w.z = cvt_pk_bf16(v1[0], v1[1]); w.w = cvt_pk_bf16(v1[2], v1[3]);
                *(u32x4*)rowp = w; }
    }
};
struct EpiBf16N {
    static constexpr bool PERM = true, AFTER_DRAIN = false;
    bf16_t* O; int ldc; int ssidx, l;
    __device__ __forceinline__ void operator()(const f32x4 (&acc)[2][2][4][2], const Unit& u, int wr, int wc, int fr, int fq) const {
        const auto kp = KARGS(); unsigned char* ws = kp->ws;
        const float* SS = ssidx >= 0 ? (const float*)(ws + WS_SS) + (size_t)ssidx * MT : nullptr; const float* SW = (const float*)(ws + WS_SWPR) + (size_t)l * 9 * 3072; constexpr int ldsw = 3072;
        const int row0 = u.pm * BM + wr * 64 + fr; const int col0 = u.pn * BM + wc * 32 + 8 * fq;
        const int mb = u.pm < 128 ? (u.pm >> 4) : 8;
        f32x4 bv[2][2];
#pragma unroll
        for (int bj = 0; bj < 2; ++bj)
#pragma unroll
            for (int n = 0; n < 2; ++n) bv[bj][n] = SS ? *(const f32x4*)(SW + (size_t)mb * ldsw + col0 + bj * HALF + 4 * n) : (f32x4){0.f, 0.f, 0.f, 0.f};
#pragma unroll
        for (int ai = 0; ai < 2; ++ai)
#pragma unroll
            for (int m = 0; m < 4; ++m) { const int row = row0 + ai * HALF + m * 16; bf16_t* rowp = O + (size_t)row * ldc + col0;
                const float rstd = SS ? __builtin_amdgcn_rsqf(SS[row] * (1.0f / 1024.0f) + NEPS) : 1.0f;
#pragma unroll
                for (int bj = 0; bj < 2; ++bj) { const f32x4 v0 = acc[ai][bj][m][0] * rstd + bv[bj][0], v1 = acc[ai][bj][m][1] * rstd + bv[bj][1];
                    u32x4 w; w.x = cvt_pk_bf16(v0[0], v0[1]); w.y = cvt_pk_bf16(v0[2], v0[3]); w.z = cvt_pk_bf16(v1[0], v1[1]); w.w = cvt_pk_bf16(v1[2], v1[3]);
                    *(u32x4*)(rowp + bj * HALF) = w; } }
    }
};
struct EpiRes {
    static constexpr bool PERM = false, AFTER_DRAIN = false;
    int l, s;
    __device__ __forceinline__ void operator()(const f32x4 (&acc)[2][2][4][2], const Unit& u, int wr, int wc, int fr, int fq) const {
        const auto kp = KARGS(); unsigned char* ws = kp->ws;
        const bool first = (l == 0 && s == 2);
        float* dstL = kp->out; float* dstC = (float*)(ws + WS_XC);
        const float* srcL = first ? kp->in[0] : dstL; const float* srcC = first ? kp->in[2] : dstC;
        const float* gate = (const float*)(ws + WS_MOD) + (size_t)l * 9 * 9216 + (s == 2 ? 2 : (s == 9 ? 5 : 8)) * 1024; const float f = s == 9 ? 1.0f : 0.5f;
        const int nxt = s == 2 ? l * 3 + 1 : (s == 9 ? l * 3 + 2 : l * 3 + 3);
        const float* gm = nxt < 12 ? (const float*)(ws + WS_GM) + (size_t)nxt * 9 * 1024 : nullptr;
        bf16_t* XG = s == 9 ? (bf16_t*)(ws + WS_TMP + T_XG2) : (bf16_t*)(ws + WS_XN); float* SS = (float*)(ws + WS_SS) + (size_t)(nxt < 12 ? nxt : 0) * MT;
        const int pm = u.pm; const int mb = pm < 128 ? (pm >> 4) : 8;
        const float* src = pm < 128 ? srcL + (size_t)pm * 256 * 1024 : srcC + (size_t)(pm - 128) * 256 * 1024;
        float* dst = pm < 128 ? dstL + (size_t)pm * 256 * 1024 : dstC + (size_t)(pm - 128) * 256 * 1024;
        const float* gp = gate + (size_t)mb * 9216;
        const int col0 = u.pn * BM + wc * 32 + 4 * fq;
        f32x4 gv[2][2], gmv[2][2];
#pragma unroll
        for (int bj = 0; bj < 2; ++bj)
#pragma unroll
            for (int n = 0; n < 2; ++n) { gv[bj][n] = *(const f32x4*)(gp + col0 + bj * HALF + n * 16) * f;
                gmv[bj][n] = gm ? *(const f32x4*)(gm + (size_t)mb * 1024 + col0 + bj * HALF + n * 16) : (f32x4){0.f, 0.f, 0.f, 0.f}; }
#pragma unroll
        for (int ai = 0; ai < 2; ++ai)
#pragma unroll
            for (int m = 0; m < 4; ++m) { const int r = ai * HALF + wr * 64 + m * 16 + fr; const size_t off = (size_t)r * 1024 + col0; float ss = 0.f;
#pragma unroll
                for (int bj = 0; bj < 2; ++bj)
#pragma unroll
                    for (int n = 0; n < 2; ++n) { const f32x4 b = *(const f32x4*)(src + off + bj * HALF + n * 16);
                        const f32x4 o = b + gv[bj][n] * acc[ai][bj][m][n];
                        *(f32x4*)(dst + off + bj * HALF + n * 16) = o;
                        if (gm) { ss += (o[0] * o[0] + o[1] * o[1]) + (o[2] * o[2] + o[3] * o[3]); const f32x4 xg = o * gmv[bj][n];
                            u32x2 w; w.x = cvt_pk_bf16(xg[0], xg[1]); w.y = cvt_pk_bf16(xg[2], xg[3]);
                            *(u32x2*)(XG + (size_t)pm * 256 * 1024 + off + bj * HALF + n * 16) = w; } }
                if (gm) { ss += __shfl_xor(ss, 16); ss += __shfl_xor(ss, 32);
                    if (fq == 0) __hip_atomic_fetch_add(SS + pm * 256 + r, ss, __ATOMIC_RELAXED, __HIP_MEMORY_SCOPE_AGENT); } }
    }
};
template <class Epi, class Sched, bool ALIGN_EPI = false, bool SP2 = false>
__device__ __forceinline__ void gemm_phase(PG8_LAS unsigned char* lds, const Gemm g, const Sched& S, const Epi& E) {
    int tid_ = threadIdx.x; asm volatile("" : "+v"(tid_)); const int tid = tid_, wid = __builtin_amdgcn_readfirstlane(tid >> 6), lane = tid & 63, wr = wid >> 2, wc = wid & 3, fr = lane & 15, fq = lane >> 4;
    const int K = g.K;
    unsigned voffA[2], voffB[2];
#pragma unroll
    for (int i = 0; i < 2; ++i) { int R, C; stage_rc(tid * 16 + i * 8192, R, C); const int Rb = Epi::PERM ? ((R & ~31) + perm32(R & 31)) : R;
        voffA[i] = (unsigned)(R * K + C) * 2u; voffB[i] = (unsigned)(Rb * K + C) * 2u; }
    const size_t kstep = (size_t)(BK * 2);
    const size_t hstep = (size_t)HALF * K * 2;
    const size_t tstep = 2 * hstep;
    const unsigned ldsw = (unsigned)wid * 1024u;
    const int aoff = lds_byte(wr * 64 + fr, fq * 8), boff = lds_byte(wc * 32 + fr, fq * 8);
#define PG8_SA(b, h) (((b) * 2 + (h)) * HTB)
#define PG8_SB(b, h) ((4 + (b) * 2 + (h)) * HTB)
#define PG8_STAGE(bufoff, gbase, voff) do { _Pragma("unroll") for (int _i = 0; _i < 2; ++_i) \
        __builtin_amdgcn_global_load_lds((const unsigned*)((const char*)(gbase) + (voff)[_i]), (PG8_LAS unsigned*)(lds + (bufoff) + ldsw + _i * 8192), 16, 0, 0); } while (0)
#define PG8_LDA(dst, b, h) do { _Pragma("unroll") for (int m = 0; m < 4; ++m) _Pragma("unroll") for (int k = 0; k < 2; ++k) dst[m][k] = *(const PG8_LAS bf16x8*)(lds + PG8_SA(b, h) + aoff + m * 2048 + k * 1024); } while (0)
#define PG8_LDB(dst, b, h) do { _Pragma("unroll") for (int n = 0; n < 2; ++n) _Pragma("unroll") for (int k = 0; k < 2; ++k) dst[n][k] = *(const PG8_LAS bf16x8*)(lds + PG8_SB(b, h) + boff + n * 2048 + k * 1024); } while (0)
#define PG8_MMA(ai, bj, At, Bt) do { __builtin_amdgcn_s_setprio(1); _Pragma("unroll") for (int m = 0; m < 4; ++m) _Pragma("unroll") for (int n = 0; n < 2; ++n) _Pragma("unroll") for (int k = 0; k < 2; ++k) \
        acc[ai][bj][m][n] = __builtin_amdgcn_mfma_f32_16x16x32_bf16(Bt[n][k], At[m][k], acc[ai][bj][m][n], 0, 0, 0); __builtin_amdgcn_s_setprio(0); } while (0)
#define PG8_WAIT_V(n) asm volatile("s_waitcnt vmcnt(" #n ")" ::: "memory")
#define PG8_WAIT_L(n) asm volatile("s_waitcnt lgkmcnt(" #n ")" ::: "memory")
#define PG8_BAR __builtin_amdgcn_s_barrier()
#define PG8_SCHED __builtin_amdgcn_sched_barrier(0)
    Unit cur, nxt; int ui = 0;
    if (!S.next(0, cur)) return;
    f32x4 acc[2][2][4][2];
#pragma unroll
    for (int a = 0; a < 2; ++a)
#pragma unroll
        for (int b = 0; b < 2; ++b)
#pragma unroll
            for (int m = 0; m < 4; ++m)
#pragma unroll
                for (int n = 0; n < 2; ++n) acc[a][b][m][n] = (f32x4){0.f, 0.f, 0.f, 0.f};
    bf16x8 At[4][2], B0[2][2], B1[2][2];
    const char* cA = (const char*)g.A + (size_t)cur.pm * tstep + (size_t)cur.kt0 * kstep; const char* cB = (const char*)g.Bt + (size_t)cur.pn * tstep + (size_t)cur.kt0 * kstep;
    S.a_ready(cur);
    if constexpr (SP2) {
        PG8_STAGE(PG8_SB(0, 0), cB, voffB); PG8_STAGE(PG8_SB(0, 1), cB + hstep, voffB); PG8_STAGE(PG8_SA(0, 0), cA, voffA); PG8_STAGE(PG8_SA(0, 1), cA + hstep, voffA);
        if (wr == 1) PG8_BAR;
        PG8_WAIT_V(2); PG8_BAR;
        PG8_STAGE(PG8_SB(1, 0), cB + kstep, voffB); PG8_STAGE(PG8_SA(1, 0), cA + kstep, voffA); PG8_STAGE(PG8_SB(1, 1), cB + hstep + kstep, voffB);
        PG8_WAIT_V(6); PG8_BAR;
    } else {
        PG8_STAGE(PG8_SB(0, 0), cB, voffB); PG8_STAGE(PG8_SA(0, 0), cA, voffA); PG8_STAGE(PG8_SB(0, 1), cB + hstep, voffB); PG8_STAGE(PG8_SA(0, 1), cA + hstep, voffA);
        if (wr == 1) PG8_BAR;
        PG8_WAIT_V(4); PG8_BAR;
        PG8_STAGE(PG8_SB(1, 0), cB + kstep, voffB); PG8_STAGE(PG8_SA(1, 0), cA + kstep, voffA); PG8_STAGE(PG8_SB(1, 1), cB + hstep + kstep, voffB);
        PG8_WAIT_V(6); PG8_BAR;
    }
    for (;;) {
        const bool has_next = S.next(ui + 1, nxt);
        const char* nA = has_next ? (const char*)g.A + (size_t)nxt.pm * tstep + (size_t)nxt.kt0 * kstep : cA; const char* nB = has_next ? (const char*)g.Bt + (size_t)nxt.pn * tstep + (size_t)nxt.kt0 * kstep : cB;
        const int nt = cur.nt;
        for (int t = 0; t < nt; t += 2) {
            const bool last = (t == nt - 2);
            const char* a1 = cA + (size_t)(t + 1) * kstep;
            const char* a2 = last ? nA : cA + (size_t)(t + 2) * kstep; const char* b2 = last ? nB : cB + (size_t)(t + 2) * kstep;
            const char* a3 = a2 + kstep; const char* b3 = b2 + kstep;
            if (last && has_next) S.a_ready(nxt);
            if constexpr (SP2) {
            PG8_LDB(B0, 0, 0); PG8_LDB(B1, 0, 1); PG8_SCHED; PG8_LDA(At, 0, 0); PG8_STAGE(PG8_SA(1, 1), a1 + hstep, voffA);
            PG8_WAIT_V(8); PG8_WAIT_L(0); PG8_BAR; PG8_MMA(0, 0, At, B0); PG8_MMA(0, 1, At, B1); PG8_BAR; PG8_SCHED;
            PG8_LDA(At, 0, 1); PG8_STAGE(PG8_SB(0, 0), b2, voffB); PG8_STAGE(PG8_SB(0, 1), b2 + hstep, voffB); PG8_STAGE(PG8_SA(0, 0), a2, voffA);
            PG8_WAIT_V(8); PG8_WAIT_L(0); PG8_BAR; PG8_MMA(1, 0, At, B0); PG8_MMA(1, 1, At, B1); PG8_BAR; PG8_SCHED;
            PG8_LDB(B0, 1, 0); PG8_LDB(B1, 1, 1); PG8_SCHED; PG8_LDA(At, 1, 0); PG8_STAGE(PG8_SA(0, 1), a2 + hstep, voffA);
            PG8_WAIT_V(8); PG8_WAIT_L(0); PG8_BAR; PG8_MMA(0, 0, At, B0); PG8_MMA(0, 1, At, B1); PG8_BAR; PG8_SCHED;
            PG8_LDA(At, 1, 1); PG8_STAGE(PG8_SB(1, 0), b3, voffB); PG8_STAGE(PG8_SB(1, 1), b3 + hstep, voffB); PG8_STAGE(PG8_SA(1, 0), a3, voffA);
            PG8_WAIT_V(8); PG8_WAIT_L(0); PG8_BAR; PG8_MMA(1, 0, At, B0); PG8_MMA(1, 1, At, B1); PG8_BAR; PG8_SCHED;
            } else {
            PG8_LDB(B0, 0, 0); PG8_SCHED; PG8_LDA(At, 0, 0); PG8_STAGE(PG8_SA(1, 1), a1 + hstep, voffA);
            PG8_WAIT_L(8); PG8_BAR; PG8_WAIT_L(0); PG8_MMA(0, 0, At, B0); PG8_BAR; PG8_SCHED;
            PG8_LDB(B1, 0, 1); PG8_STAGE(PG8_SB(0, 0), b2, voffB);
            PG8_BAR; PG8_WAIT_L(0); PG8_MMA(0, 1, At, B1); PG8_BAR;
            PG8_LDA(At, 0, 1); PG8_STAGE(PG8_SA(0, 0), a2, voffA);
            PG8_BAR; PG8_WAIT_L(0); PG8_MMA(1, 0, At, B0); PG8_BAR; PG8_SCHED;
            PG8_STAGE(PG8_SB(0, 1), b2 + hstep, voffB);
            PG8_WAIT_V(6); PG8_BAR; PG8_MMA(1, 1, At, B1); PG8_BAR;
            PG8_LDB(B0, 1, 0); PG8_SCHED; PG8_LDA(At, 1, 0); PG8_STAGE(PG8_SA(0, 1), a2 + hstep, voffA);
            PG8_WAIT_L(8); PG8_BAR; PG8_WAIT_L(0); PG8_MMA(0, 0, At, B0); PG8_BAR; PG8_SCHED;
            PG8_LDB(B1, 1, 1); PG8_STAGE(PG8_SB(1, 0), b3, voffB);
            PG8_BAR; PG8_WAIT_L(0); PG8_MMA(0, 1, At, B1); PG8_BAR;
            PG8_LDA(At, 1, 1); PG8_STAGE(PG8_SA(1, 0), a3, voffA);
            PG8_BAR; PG8_WAIT_L(0); PG8_MMA(1, 0, At, B0); PG8_BAR; PG8_SCHED;
            PG8_STAGE(PG8_SB(1, 1), b3 + hstep, voffB);
            PG8_WAIT_V(6); PG8_BAR; PG8_MMA(1, 1, At, B1); PG8_BAR;
            }
        }
        if constexpr (ALIGN_EPI) { if (wr == 0) PG8_BAR; }
        if constexpr (!Epi::AFTER_DRAIN) { E(acc, cur, wr, wc, fr, fq); S.done(cur); }
        if (!has_next) break;
#pragma unroll
        for (int a = 0; a < 2; ++a)
#pragma unroll
            for (int b = 0; b < 2; ++b)
#pragma unroll
                for (int m = 0; m < 4; ++m)
#pragma unroll
                    for (int n = 0; n < 2; ++n) acc[a][b][m][n] = (f32x4){0.f, 0.f, 0.f, 0.f};
        cur = nxt; cA = nA; cB = nB; ++ui;
        if constexpr (ALIGN_EPI) { if (wr == 1) PG8_BAR; }
    }
    PG8_WAIT_V(0);
    if constexpr (!ALIGN_EPI) { if (wr == 0) PG8_BAR; }
    PG8_BAR;
    if constexpr (Epi::AFTER_DRAIN) { E.fused(acc, cur, wr, wc, fr, fq, lds, wid, lane); S.done(cur); }
#undef PG8_SA
#undef PG8_SB
#undef PG8_STAGE
#undef PG8_LDA
#undef PG8_LDB
#undef PG8_MMA
#undef PG8_WAIT_V
#undef PG8_WAIT_L
#undef PG8_BAR
#undef PG8_SCHED
}
}

namespace att {
typedef unsigned short bf16_t;
using bf16x8 = __attribute__((ext_vector_type(8))) short;
using s16x4  = __attribute__((ext_vector_type(4))) short;
using f32x16 = __attribute__((ext_vector_type(16))) float;
using u32x4  = __attribute__((ext_vector_type(4))) unsigned;
#define SBAR() __builtin_amdgcn_sched_barrier(0)
__device__ __forceinline__ int crow(int r, int hi) { return (r & 3) + 8 * (r >> 2) + 4 * hi; }
__device__ __forceinline__ unsigned cvtpk(float lo, float hi) { unsigned r; asm volatile("v_cvt_pk_bf16_f32 %0, %1, %2" : "=v"(r) : "v"(lo), "v"(hi)); return r; }
__device__ __forceinline__ bf16x8 ld8(const bf16_t* p) { return *reinterpret_cast<const bf16x8*>(p); }
__device__ __forceinline__ unsigned short f2bf1(float f) { unsigned u = __builtin_bit_cast(unsigned, f); return (unsigned short)((u + 0x7fffu + ((u >> 16) & 1u)) >> 16); }

struct AUnit {
  const bf16_t* q;
  const bf16_t* k1c; const bf16_t* k1l;
  const bf16_t* k2c; const bf16_t* k2l;
  const bf16_t* vc; const bf16_t* vl;
  bf16_t* o;
  int nt, nctx; float C;
  int R0, klo; const float* rpb;
};

__device__ __forceinline__ void partialSM(f32x16& p0, f32x16& p1, float& m_reg, float& mn, float& alpha, const float C, const float thr) {
  float pmax = p0[0];
#pragma unroll
  for (int r = 1; r < 16; ++r) pmax = fmaxf(pmax, p0[r]);
#pragma unroll
  for (int r = 0; r < 16; ++r) pmax = fmaxf(pmax, p1[r]);
  { auto rr = __builtin_amdgcn_permlane32_swap(__float_as_uint(pmax), __float_as_uint(pmax), false, false);
    pmax = fmaxf(__uint_as_float(rr[0]), __uint_as_float(rr[1])); }
  if (__builtin_expect(__all(pmax - m_reg <= thr), 1)) { mn = m_reg; alpha = 1.f; }
  else { mn = fmaxf(m_reg, pmax); alpha = __builtin_amdgcn_exp2f((m_reg - mn) * C); m_reg = mn; }
  float mnC = -mn * C;
#pragma unroll
  for (int r = 0; r < 16; ++r) p0[r] = fmaf(p0[r], C, mnC);
#pragma unroll
  for (int r = 0; r < 16; ++r) p1[r] = fmaf(p1[r], C, mnC);
#pragma unroll
  for (int r = 0; r < 16; ++r) p0[r] = __builtin_amdgcn_exp2f(p0[r]);
}
__device__ __forceinline__ void finishSM(f32x16& p0, f32x16& p1, float alpha, float& l_reg, bf16x8& pa0, bf16x8& pa1, bf16x8& pa2, bf16x8& pa3) {
#pragma unroll
  for (int r = 0; r < 16; ++r) p1[r] = __builtin_amdgcn_exp2f(p1[r]);
  float ps = 0;
#pragma unroll
  for (int r = 0; r < 16; ++r) ps += p0[r];
#pragma unroll
  for (int r = 0; r < 16; ++r) ps += p1[r];
  { auto rr = __builtin_amdgcn_permlane32_swap(__float_as_uint(ps), __float_as_uint(ps), false, false);
    ps = __uint_as_float(rr[0]) + __uint_as_float(rr[1]); }
  l_reg = l_reg * alpha + ps;
#define PK4(P, BASE, OUT) do { unsigned a0 = cvtpk(P[BASE + 0], P[BASE + 1]), a1 = cvtpk(P[BASE + 2], P[BASE + 3]);   \
    unsigned b0 = cvtpk(P[BASE + 4], P[BASE + 5]), b1 = cvtpk(P[BASE + 6], P[BASE + 7]);                              \
    auto r0 = __builtin_amdgcn_permlane32_swap(a0, b0, false, false); auto r1 = __builtin_amdgcn_permlane32_swap(a1, b1, false, false); \
    u32x4 w = {r0[0], r1[0], r0[1], r1[1]}; OUT = *reinterpret_cast<bf16x8*>(&w); } while (0)
  PK4(p0, 0, pa0); PK4(p0, 8, pa1); PK4(p1, 0, pa2); PK4(p1, 8, pa3);
#undef PK4
}
template <int DK> __device__ __forceinline__ int kswz(int row, int colB) { return row * (DK * 2) + (colB ^ ((row & 7) << 4)); }
template <int DK> __device__ __forceinline__ void qkt(f32x16& p0, f32x16& p1, const char* Ks, const bf16x8* qr, const char* qlds, int r32, int hi) {
  p0 = f32x16{}; p1 = f32x16{};
#pragma unroll
  for (int d0 = 0; d0 < DK / 16; ++d0) { int cb = (d0 * 16 + hi * 8) * 2;
    bf16x8 b0 = *reinterpret_cast<const bf16x8*>(Ks + kswz<DK>(r32, cb));
    bf16x8 b1 = *reinterpret_cast<const bf16x8*>(Ks + kswz<DK>(32 + r32, cb));
    bf16x8 qf;
    if (DK == 192 && d0 >= 8) qf = *reinterpret_cast<const bf16x8*>(qlds + (d0 - 8) * 1024); else qf = qr[d0 < 8 ? d0 : 0];
    p0 = __builtin_amdgcn_mfma_f32_32x32x16_bf16(b0, qf, p0, 0, 0, 0);
    p1 = __builtin_amdgcn_mfma_f32_32x32x16_bf16(b1, qf, p1, 0, 0, 0); }
}
template <int DV> __device__ __forceinline__ int v_st(int k, int c) { const int kk = (k & ~0xC) | ((k & 4) << 1) | ((k & 8) >> 1); return ((kk >> 3) * (DV / 32) + (c >> 5)) * 512 + ((kk & 7) * 32 + (c & 31)) * 2; }
__device__ __forceinline__ int v_rd_base(int lane) { return ((lane & 3) << 3) | (((lane >> 2) & 3) << 6) | (((lane >> 4) & 1) << 5) | (((lane >> 5) & 1) << 8); }
template <int DV> constexpr int v_rd_off(int d0, int ks, int half) { return d0 * 512 + ks * (2 * (DV / 32) * 512) + half * ((DV / 32) * 512); }
template <int OFF> __device__ __forceinline__ s16x4 tr_read(int vb) {
  s16x4 r; asm volatile("ds_read_b64_tr_b16 %0, %1 offset:%2" : "=&v"(r) : "v"(vb), "i"(OFF) : "memory"); return r;
}
template <int D0, int DV> __device__ __forceinline__ void pv_one(f32x16& od, int vb, bf16x8 pa0, bf16x8 pa1, bf16x8 pa2, bf16x8 pa3) {
  const s16x4 l0 = tr_read<v_rd_off<DV>(D0, 0, 0)>(vb), h0 = tr_read<v_rd_off<DV>(D0, 0, 1)>(vb), l1 = tr_read<v_rd_off<DV>(D0, 1, 0)>(vb), h1 = tr_read<v_rd_off<DV>(D0, 1, 1)>(vb);
  const s16x4 l2 = tr_read<v_rd_off<DV>(D0, 2, 0)>(vb), h2 = tr_read<v_rd_off<DV>(D0, 2, 1)>(vb), l3 = tr_read<v_rd_off<DV>(D0, 3, 0)>(vb), h3 = tr_read<v_rd_off<DV>(D0, 3, 1)>(vb);
  asm volatile("s_waitcnt lgkmcnt(0)" ::: "memory"); SBAR();
#define PK(L, H) (bf16x8){L[0], L[1], L[2], L[3], H[0], H[1], H[2], H[3]}
  od = __builtin_amdgcn_mfma_f32_32x32x16_bf16(pa0, PK(l0, h0), od, 0, 0, 0);
  od = __builtin_amdgcn_mfma_f32_32x32x16_bf16(pa1, PK(l1, h1), od, 0, 0, 0);
  od = __builtin_amdgcn_mfma_f32_32x32x16_bf16(pa2, PK(l2, h2), od, 0, 0, 0);
  od = __builtin_amdgcn_mfma_f32_32x32x16_bf16(pa3, PK(l3, h3), od, 0, 0, 0);
#undef PK
}
template <int DV> __device__ __forceinline__ void pv_all(f32x16* o, int vb, bf16x8 pa0, bf16x8 pa1, bf16x8 pa2, bf16x8 pa3) {
  pv_one<0, DV>(o[0], vb, pa0, pa1, pa2, pa3); pv_one<1, DV>(o[1], vb, pa0, pa1, pa2, pa3);
  if constexpr (DV == 128) { pv_one<2, DV>(o[2], vb, pa0, pa1, pa2, pa3); pv_one<3, DV>(o[3], vb, pa0, pa1, pa2, pa3); }
}
__device__ __forceinline__ void nb_mask(f32x16& p0, f32x16& p1, bool rowok, int tbase, int cs, int hi, const float* T) {
#pragma unroll
  for (int r = 0; r < 16; ++r) { const int kc = crow(r, hi);
    const bool in0 = rowok && kc >= cs && kc < cs + 16; const float b0 = T[tbase + kc]; p0[r] = in0 ? p0[r] + b0 : -1e30f;
    const int kc1 = kc + 32;
    const bool in1 = rowok && kc1 >= cs && kc1 < cs + 16; const float b1 = T[tbase + kc1]; p1[r] = in1 ? p1[r] + b1 : -1e30f; }
}

template <int DK, int DV> constexpr int attn_lds_bytes() { return 2 * 64 * DV * 2 + 2 * 64 * DK * 2 + 2048 + 15 * 128 * 4; }

template <int DK, int DV, int MODE, int SD, int LDQ, int LDK1, int LDK2, int LDV, int LDO>
__device__ __forceinline__ void attn_unit(const AUnit& u, char* lds) {
  constexpr int KBYT = 64 * DK * 2, VBYT = 64 * DV * 2, ND = DK / 16, NO = DV / 32;
  constexpr int OFF_WS = 2 * VBYT + 2 * KBYT, OFF_T = OFF_WS + 2048, OFF_Q = OFF_T + 15 * 128 * 4, NDR = ND > 8 ? 8 : ND;
  constexpr int NLD = (DK == 192 ? 3 : (DK == 128 ? 2 : 1)) + (DV == 128 ? 2 : 1);
  int tid_ = threadIdx.x; asm volatile("" : "+v"(tid_)); const int tid = tid_, wid = __builtin_amdgcn_readfirstlane(tid >> 6), lane = tid & 63, r32 = lane & 31, hi = lane >> 5;
  char* V_lds = lds; char* K_lds = lds + 2 * VBYT;
  float* wsf = (float*)(lds + OFF_WS) + wid * 64; float* li_l = wsf; float* al_l = wsf + 32;
  float* T = (float*)(lds + OFF_T);
  __syncthreads();
  int qrow = 0, qcol = 0, r0w = 0, cs = 0;
  if constexpr (MODE == 1) {
    if (u.nt > u.nctx) { for (int e = tid; e < 15 * 128; e += 512) { const int ro = e >> 7, d = (e & 127) - 64; T[e] = (d >= -15 && d <= 15) ? 8.0f * u.rpb[ro * 31 + d + 15] : 0.f; } }
    qrow = u.R0 + (wid >> 1); qcol = (wid & 1) * 32 + r32;
    r0w = qrow - 4; r0w = r0w < 0 ? 0 : (r0w > 56 ? 56 : r0w);
    cs = qcol - 8; cs = cs < 0 ? 0 : (cs > 48 ? 48 : cs);
  }
  const float C = u.C, thr = 8.0f * 1.4426950408889634f / C;
  float m_reg = -1e30f, l_reg = 0; f32x16 o[NO] = {}; bf16x8 qr[NDR];
  char* qlds = lds + OFF_Q + wid * 4096 + lane * 16;
  const bf16_t* Qw = u.q + (unsigned)((wid * 32 + r32) * LDQ + hi * 8);
#pragma unroll
  for (int d0 = 0; d0 < NDR; ++d0) qr[d0] = ld8(Qw + d0 * 16);
  if constexpr (DK == 192) {
#pragma unroll
    for (int d0 = 0; d0 < 4; ++d0) *reinterpret_cast<bf16x8*>(qlds + d0 * 1024) = ld8(Qw + (8 + d0) * 16); }
  const int sr = tid >> 4, sc = (tid & 15) * 8, sr6 = tid >> 3, sc6 = (tid & 7) * 8;
  const unsigned kof = (DK >= 128 ? (unsigned)(sr * LDK1 + sc) : (unsigned)(sr6 * LDK1 + sc6)) * 2u, k2of = (unsigned)(sr6 * LDK2 + sc6) * 2u, vof = (DV == 128 ? (unsigned)(sr * LDV + sc) : (unsigned)(sr6 * LDV + sc6)) * 2u;
  const int vb0 = (int)(uintptr_t)V_lds + v_rd_base(lane);
  struct { bf16x8 k0, k1, k2, v0, v1; } st[SD];
#define TILEP(bc, bl, ld, j) ((const char*)((j) < u.nctx ? (bc) + (long)(j) * 64 * (ld) : (bl) + (long)((j) - u.nctx) * 64 * (ld)))
#define LDB(base, off) (*reinterpret_cast<const bf16x8*>((base) + (off)))
#define SLOAD(i, j) do { const char* kp_ = TILEP(u.k1c, u.k1l, LDK1, j); const char* vp_ = TILEP(u.vc, u.vl, LDV, j); \
    if constexpr (DK >= 128) { st[i].k0 = LDB(kp_, kof); st[i].k1 = LDB(kp_ + 32 * LDK1 * 2, kof); } \
    if constexpr (DK == 192) { const char* k2_ = TILEP(u.k2c, u.k2l, LDK2, j); st[i].k2 = LDB(k2_, k2of); } \
    if constexpr (DK == 64) { st[i].k0 = LDB(kp_, kof); } \
    if constexpr (DV == 128) { st[i].v0 = LDB(vp_, vof); st[i].v1 = LDB(vp_ + 32 * LDV * 2, vof); } \
    else { st[i].v0 = LDB(vp_, vof); } } while (0)
#define SWRITE(b, i) do { \
    if constexpr (DV == 128) { *(bf16x8*)(V_lds + (b) * VBYT + v_st<DV>(sr, sc)) = st[i].v0; *(bf16x8*)(V_lds + (b) * VBYT + v_st<DV>(32 + sr, sc)) = st[i].v1; } \
    else { *(bf16x8*)(V_lds + (b) * VBYT + v_st<DV>(sr6, sc6)) = st[i].v0; } \
    if constexpr (DK >= 128) { *(bf16x8*)(K_lds + (b) * KBYT + kswz<DK>(sr, sc * 2)) = st[i].k0; *(bf16x8*)(K_lds + (b) * KBYT + kswz<DK>(32 + sr, sc * 2)) = st[i].k1; } \
    if constexpr (DK == 192) { *(bf16x8*)(K_lds + (b) * KBYT + kswz<DK>(sr6, 256 + sc6 * 2)) = st[i].k2; } \
    if constexpr (DK == 64) { *(bf16x8*)(K_lds + (b) * KBYT + kswz<DK>(sr6, sc6 * 2)) = st[i].k0; } } while (0)
#define SWAIT() do { if constexpr (SD == 2 && NLD == 4) asm volatile("s_waitcnt vmcnt(4)" ::: "memory"); else if constexpr (SD == 2 && NLD == 2) asm volatile("s_waitcnt vmcnt(2)" ::: "memory"); \
    else asm volatile("s_waitcnt vmcnt(0)" ::: "memory"); } while (0)
#define RESC(a) do { if (__any((a) < 1.f)) { if (hi == 0) al_l[r32] = (a); asm volatile("s_waitcnt lgkmcnt(0)" ::: "memory"); \
    _Pragma("unroll") for (int d = 0; d < NO; ++d) _Pragma("unroll") for (int r = 0; r < 16; ++r) o[d][r] *= al_l[crow(r, hi)]; } } while (0)
#define MASK(P0, P1, j) do { if constexpr (MODE == 1) { if ((j) >= u.nctx) { const int krow_ = u.klo + (j) - u.nctx; const bool rowok_ = krow_ >= r0w && krow_ < r0w + 8; \
    int dr_ = krow_ - qrow + 7; dr_ = dr_ < 0 ? 0 : (dr_ > 14 ? 14 : dr_); nb_mask(P0, P1, rowok_, dr_ * 128 + 64 - qcol, cs, hi, T); } } } while (0)
  f32x16 pA0, pA1, pB0, pB1; float mnA, mnB, alA, alB; bf16x8 pa0, pa1, pa2, pa3; const int NT = u.nt;
  constexpr int SE = 0, SO = SD - 1;
  SLOAD(SE, 0); asm volatile("s_waitcnt vmcnt(0)" ::: "memory"); SWRITE(0, SE); __syncthreads();
  qkt<DK>(pA0, pA1, K_lds, qr, qlds, r32, hi); MASK(pA0, pA1, 0); partialSM(pA0, pA1, m_reg, mnA, alA, C, thr);
  SLOAD(SO, 1); if constexpr (SD == 2) { if (2 < NT) SLOAD(SE, 2); }
  SWAIT(); SWRITE(1, SO); __syncthreads();
  for (int j = 1; j + 1 < NT; j += 2) {
    SBAR(); qkt<DK>(pB0, pB1, K_lds + KBYT, qr, qlds, r32, hi); MASK(pB0, pB1, j);
    finishSM(pA0, pA1, alA, l_reg, pa0, pa1, pa2, pa3); SBAR();
    SLOAD(SO, j + SD); SBAR();
    pv_all<DV>(o, vb0, pa0, pa1, pa2, pa3); partialSM(pB0, pB1, m_reg, mnB, alB, C, thr);
    __syncthreads(); SWAIT(); SWRITE(0, SE);
    RESC(alB); __syncthreads();
    SBAR(); qkt<DK>(pA0, pA1, K_lds, qr, qlds, r32, hi); MASK(pA0, pA1, j + 1);
    finishSM(pB0, pB1, alB, l_reg, pa0, pa1, pa2, pa3); SBAR();
    if (SD == 1 || j + 3 < NT) SLOAD(SE, j + 1 + SD); SBAR();
    pv_all<DV>(o, vb0 + VBYT, pa0, pa1, pa2, pa3); partialSM(pA0, pA1, m_reg, mnA, alA, C, thr);
    __syncthreads(); SWAIT(); SWRITE(1, SO);
    RESC(alA); __syncthreads();
  }
  SBAR(); qkt<DK>(pB0, pB1, K_lds + KBYT, qr, qlds, r32, hi); MASK(pB0, pB1, NT - 1);
  finishSM(pA0, pA1, alA, l_reg, pa0, pa1, pa2, pa3); SBAR();
  pv_all<DV>(o, vb0, pa0, pa1, pa2, pa3); partialSM(pB0, pB1, m_reg, mnB, alB, C, thr);
  __syncthreads(); RESC(alB);
  finishSM(pB0, pB1, alB, l_reg, pa0, pa1, pa2, pa3); SBAR();
  pv_all<DV>(o, vb0 + VBYT, pa0, pa1, pa2, pa3);
  if (hi == 0) li_l[r32] = l_reg; asm volatile("s_waitcnt lgkmcnt(0)" ::: "memory");
  float rli[16];
#pragma unroll
  for (int r = 0; r < 16; ++r) rli[r] = __builtin_amdgcn_rcpf(li_l[crow(r, hi)]);
  bf16_t* Ow = u.o + (long)(wid * 32) * LDO;
#pragma unroll
  for (int r = 0; r < 16; ++r) { const int orow = crow(r, hi);
#pragma unroll
    for (int d0 = 0; d0 < NO; ++d0) Ow[orow * LDO + d0 * 32 + r32] = f2bf1(o[d0][r] * rli[r]); }
#undef TILEP
#undef LDB
#undef SLOAD
#undef SWRITE
#undef SWAIT
#undef RESC
#undef MASK
}
#undef SBAR
}
#ifndef EN
#define EN 127
#endif
#ifndef AEN
#define AEN 7
#endif
#ifndef REP_ATTN
#define REP_ATTN 1
#endif
#ifndef REP_UP
#define REP_UP 1
#endif
#ifndef REP_NORM
#define REP_NORM 1
#endif
#ifndef REP_PLAIN
#define REP_PLAIN 1
#endif
#ifndef EXTRA_SYNCS
#define EXTRA_SYNCS 0
#endif
#ifndef REP_PRO
#define REP_PRO 1
#endif
#ifndef REP_PRE
#define REP_PRE 1
#endif
#ifndef REP_A1
#define REP_A1 1
#endif

#define LAS __attribute__((address_space(3)))
typedef float f32x4 __attribute__((ext_vector_type(4)));
typedef unsigned u32x4v __attribute__((ext_vector_type(4)));
typedef unsigned u32x2v __attribute__((ext_vector_type(2)));

__device__ __forceinline__ unsigned f2bf(float f) { unsigned u = __builtin_bit_cast(unsigned, f); return (u + 0x7fffu + ((u >> 16) & 1u)) >> 16; }
__device__ __forceinline__ unsigned pk2(float lo, float hi) { return f2bf(lo) | (f2bf(hi) << 16); }
__device__ __forceinline__ float bf2f(unsigned short b) { return __builtin_bit_cast(float, (unsigned)b << 16); }
__device__ __forceinline__ float bflo(unsigned w) { return __builtin_bit_cast(float, w << 16); }
__device__ __forceinline__ float bfhi(unsigned w) { return __builtin_bit_cast(float, w & 0xffff0000u); }
__device__ __forceinline__ float wave_sum(float v) {
#pragma unroll
    for (int o = 1; o < 64; o <<= 1) v += __shfl_xor(v, o);
    return v;
}
#define LDS_WAIT() asm volatile("s_waitcnt lgkmcnt(0)" ::: "memory")

__device__ __forceinline__ void transpose_item(const float* W, int K, int N, bf16_t* WT, int mode, LAS float* scr, int item, int lane) {
    const int nblk = N / 32, kb = item / nblk, nb = item % nblk, k0 = 64 * kb, n0 = 32 * nb;
    int drow0 = n0;
    if (mode == 1) drow0 = n0 < DFF ? ((n0 >> 7) * 256 + (n0 & 127)) : (((n0 - DFF) >> 7) * 256 + 128 + ((n0 - DFF) & 127));
#pragma unroll 8
    for (int i = 0; i < 32; ++i) { const int kk = 2 * i + (lane >> 5); scr[kk * 33 + (lane & 31)] = W[(size_t)(k0 + kk) * N + n0 + (lane & 31)]; }
    LDS_WAIT(); asm volatile("" ::: "memory");
    const int c = lane & 7;
#pragma unroll
    for (int j = 0; j < 4; ++j) { const int n = (lane >> 3) + 8 * j; const LAS float* s = scr + (8 * c) * 33 + n;
        u32x4v o; o.x = pk2(s[0 * 33], s[1 * 33]); o.y = pk2(s[2 * 33], s[3 * 33]); o.z = pk2(s[4 * 33], s[5 * 33]); o.w = pk2(s[6 * 33], s[7 * 33]);
        *(u32x4v*)(WT + (size_t)(drow0 + n) * K + k0 + 8 * c) = o; }
    LDS_WAIT(); asm volatile("" ::: "memory");
}
__device__ __forceinline__ void cvt_job(const KP& p, bf16_t* Wb, int job, const float*& src, int& K, int& N, bf16_t*& dst, int& mode) {
    mode = 0;
    if (job < 16) { const int l = job >> 2, t = job & 3; bf16_t* lb = Wb + (size_t)l * W_LAYER;
        if (t == 0)      { src = p.in[7]  + (size_t)l * 1024 * 5632; K = 1024; N = 5632; dst = lb + W_13A; mode = 1; }
        else if (t == 1) { src = p.in[8]  + (size_t)l * 2816 * 1024; K = 2816; N = 1024; dst = lb + W_2A; }
        else if (t == 2) { src = p.in[9]  + (size_t)l * 1024 * 5632; K = 1024; N = 5632; dst = lb + W_13B; mode = 1; }
        else             { src = p.in[10] + (size_t)l * 2816 * 1024; K = 2816; N = 1024; dst = lb + W_2B; }
    } else if (job < 24) { const int a = job - 16, j = a >> 2, t = a & 3; bf16_t* mb = Wb + W_MX + (size_t)j * W_ASZ;
        if (t == 0)      { src = p.in[11] + (size_t)j * 1024 * 704;  K = 1024; N = 704;  dst = mb + W_A_IN; }
        else if (t == 1) { src = p.in[14] + (size_t)j * 384 * 1536;  K = 384;  N = 1536; dst = mb + W_A_UQ; }
        else if (t == 2) { src = p.in[15] + (size_t)j * 256 * 2048;  K = 256;  N = 2048; dst = mb + W_A_UKV; }
        else             { src = p.in[16] + (size_t)j * 1024 * 1024; K = 1024; N = 1024; dst = mb + W_A_O; }
    } else if (job == 24) { src = p.in[17]; K = 1024; N = 1536; dst = Wb + W_MXB + W_B_QKV; }
    else if (job == 25)   { src = p.in[20]; K = 1024; N = 1024; dst = Wb + W_MXB + W_B_O; }
    else if (job == 26)   { src = p.in[21]; K = 1024; N = 3072; dst = Wb + W_MXC + W_C_QKV; }
    else                  { src = p.in[23]; K = 1024; N = 1024; dst = Wb + W_MXC + W_C_O; }
}
__device__ __forceinline__ void gemv9_item(LAS float* sv, LAS float* red, const float* W, int ldw, int N, int n0, const float* bias, float* out, int ldo, int tid) {
    const int cg4 = tid & 31, ks = tid >> 5;
    const bool cv = n0 + cg4 * 4 < N;
    const float* wp = W + (size_t)(ks * 64) * ldw + n0 + cg4 * 4;
    f32x4 acc[9];
#pragma unroll
    for (int j = 0; j < 9; ++j) acc[j] = (f32x4){0.f, 0.f, 0.f, 0.f};
    if (cv) {
#pragma unroll 4
        for (int k = 0; k < 64; ++k) { const f32x4 w = *(const f32x4*)(wp + (size_t)k * ldw);
#pragma unroll
            for (int j = 0; j < 9; ++j) acc[j] += w * sv[j * 1024 + ks * 64 + k]; }
    }
#pragma unroll
    for (int j = 0; j < 9; ++j) *(LAS f32x4*)(red + (ks * 9 + j) * 128 + cg4 * 4) = acc[j];
    __syncthreads();
    for (int e = tid; e < 9 * 128; e += 512) { const int j = e >> 7, cidx = e & 127;
        if (n0 + cidx < N) { float s = bias ? bias[n0 + cidx] : 0.f;
#pragma unroll
            for (int q = 0; q < 16; ++q) s += red[(q * 9 + j) * 128 + cidx];
            out[(size_t)j * ldo + n0 + cidx] = s; } }
    __syncthreads();
}
__device__ __forceinline__ void prologue_phase(const KP& p, LAS unsigned char* lds, int tid, int lane, int wave, int G) {
    bf16_t* Wb = (bf16_t*)(p.ws + WS_W);
    {
        LAS float* sv = (LAS float*)lds;
        LAS float* red = (LAS float*)(lds + 40960);
        const float* c = p.in[1]; const float* cc = p.in[3];
        for (int e = tid; e < 9 * 1024; e += 512) { const float x = e < 8192 ? c[e] : cc[e - 8192]; sv[e] = x / (1.0f + __expf(-x)); }
        __syncthreads();
        float* MOD = (float*)(p.ws + WS_MOD);
        for (int item = blockIdx.x; item < 288; item += G) {
            const int colg = item * 128, l = colg / 9216, n0 = colg % 9216;
            gemv9_item(sv, red, p.in[5] + (size_t)l * 1024 * 9216, 9216, 9216, n0, p.in[6] + (size_t)l * 9216, MOD + (size_t)l * 9 * 9216, 9216, tid);
        }
        float* SS = (float*)(p.ws + WS_SS);
        for (int e = blockIdx.x * 512 + tid; e < 12 * MT / 4; e += G * 512) *(f32x4*)(SS + (size_t)e * 4) = (f32x4){0.f, 0.f, 0.f, 0.f};
    }
    __syncthreads();
    {
        LAS float* scr = (LAS float*)(lds + wave * 16384);
        const int gw = blockIdx.x * 8 + wave, NGW = G * 8;
        int base = 0;
        for (int job = 0; job < 28; ++job) {
            const float* src; int K, N, mode; bf16_t* dst;
            cvt_job(p, Wb, job, src, K, N, dst, mode);
            const int nitems = (K / 64) * (N / 32);
            int first = gw - base; if (first < 0) first += NGW;
            for (int it = first; it < nitems; it += NGW) transpose_item(src, K, N, dst, mode, scr, it, lane);
            base = (base + nitems) % NGW;
        }
        for (int e = blockIdx.x * 512 + tid; e < 2 * 64 * 1024 / 8; e += G * 512) { const int j = e / 8192, r = e % 8192;
            *(u32x4v*)(Wb + W_MX + (size_t)j * W_ASZ + W_A_IN + (size_t)704 * 1024 + (size_t)r * 8) = (u32x4v){0u, 0u, 0u, 0u}; }
    }
}

__device__ __forceinline__ void pre_phase(const KP& p, LAS unsigned char* lds, int tid, int lane, int wave, int G) {
    const float* MOD = (const float*)(p.ws + WS_MOD);
    {
        LAS float* sv = (LAS float*)lds; LAS float* red = (LAS float*)(lds + 40960);
        float* SWUP = (float*)(p.ws + WS_SWUP); float* SWPR = (float*)(p.ws + WS_SWPR);
        for (int it = blockIdx.x; it < 400; it += G) {
            const float* W; int ldw, N, n0, l, chunk; float* out; int ldo;
            if (it < 352) { const int job = it / 44; l = job >> 1; const int half = job & 1; W = p.in[half ? 9 : 7] + (size_t)l * 1024 * 5632; ldw = 5632; N = 5632; n0 = (it % 44) * 128; chunk = half ? 6 : 0; out = SWUP + (size_t)job * 9 * 5632; ldo = 5632; }
            else { int r = it - 352; chunk = 3; ldo = 3072;
                if (r < 6) { l = 0; W = p.in[11]; N = 704; }
                else if (r < 18) { r -= 6; l = 1; W = p.in[17]; N = 1536; }
                else if (r < 42) { r -= 18; l = 2; W = p.in[21]; N = 3072; }
                else { r -= 42; l = 3; W = p.in[11] + (size_t)1024 * 704; N = 704; }
                ldw = N; n0 = r * 128; out = SWPR + (size_t)l * 9 * 3072; }
            for (int e = tid; e < 9 * 1024; e += 512) sv[e] = MOD[((size_t)l * 9 + (e >> 10)) * 9216 + chunk * 1024 + (e & 1023)];
            __syncthreads();
            gemv9_item(sv, red, W, ldw, N, n0, nullptr, out, ldo, tid);
        }
    }
    { float* GM = (float*)(p.ws + WS_GM);
      for (int e = blockIdx.x * 512 + tid; e < 12 * 9 * 1024; e += G * 512) { const int col = e & 1023, mb = (e >> 10) % 9, lw = (e >> 10) / 9, l = lw / 3, w = lw % 3;
          GM[e] = p.in[4][(size_t)lw * 1024 + col] * (1.0f + MOD[((size_t)l * 9 + mb) * 9216 + (3 * w + 1) * 1024 + col]); } }
    { const int gw = blockIdx.x * 8 + wave, NGW = G * 8; bf16_t* XN = (bf16_t*)(p.ws + WS_XN); float* SS = (float*)(p.ws + WS_SS);
      const float* g = p.in[4];
      for (int row = gw; row < MT; row += NGW) {
          const int mb = row < ML ? (row >> 12) : 8;
          const float* xr = row < ML ? p.in[0] + (size_t)row * DM : p.in[2] + (size_t)(row - ML) * DM;
          const float* sc = MOD + (size_t)mb * 9216 + 1024;
          float ss = 0.f;
#pragma unroll
          for (int j = 0; j < 4; ++j) { const int col = (lane + 64 * j) * 4; const f32x4 v = *(const f32x4*)(xr + col);
              ss += (v.x * v.x + v.y * v.y) + (v.z * v.z + v.w * v.w);
              const f32x4 y = v * (*(const f32x4*)(g + col)) * (*(const f32x4*)(sc + col) + 1.0f);
              u32x2v w; w.x = pk2(y.x, y.y); w.y = pk2(y.z, y.w);
              *(u32x2v*)(XN + (size_t)row * DM + col) = w; }
          ss = wave_sum(ss);
          if (lane == 0) SS[row] = ss;
      } }
}

__device__ __forceinline__ void norm_phase(const float* xL, const float* xC, const float* g, const float* shift, const float* scale, bf16_t* XN, int gw, int NGW, int lane) {
    for (int row = gw; row < MT; row += NGW) {
        const int mb = row < ML ? (row >> 12) : 8;
        const float* xr = row < ML ? xL + (size_t)row * DM : xC + (size_t)(row - ML) * DM;
        f32x4 v[4]; float ss = 0.f;
#pragma unroll
        for (int j = 0; j < 4; ++j) { v[j] = *(const f32x4*)(xr + (lane + 64 * j) * 4); ss += (v[j].x * v[j].x + v[j].y * v[j].y) + (v[j].z * v[j].z + v[j].w * v[j].w); }
        const float rstd = __builtin_amdgcn_rsqf(wave_sum(ss) * (1.0f / DM) + EPS);
        const float* sh = shift + (size_t)mb * 9216; const float* sc = scale + (size_t)mb * 9216;
#pragma unroll
        for (int j = 0; j < 4; ++j) { const int col = (lane + 64 * j) * 4;
            const f32x4 gg = *(const f32x4*)(g + col), s1 = *(const f32x4*)(sc + col), s0 = *(const f32x4*)(sh + col);
            const f32x4 y = (v[j] * rstd) * gg * (s1 + 1.0f) + s0;
            u32x2v w; w.x = pk2(y.x, y.y); w.y = pk2(y.z, y.w);
            *(u32x2v*)(XN + (size_t)row * DM + col) = w; }
    }
}
__device__ __forceinline__ void final_norm_phase(float* x, const float* g, int gw, int NGW, int lane) {
    for (int row = gw; row < ML; row += NGW) {
        float* xr = x + (size_t)row * DM;
        f32x4 v[4]; float ss = 0.f;
#pragma unroll
        for (int j = 0; j < 4; ++j) { v[j] = *(const f32x4*)(xr + (lane + 64 * j) * 4); ss += (v[j].x * v[j].x + v[j].y * v[j].y) + (v[j].z * v[j].z + v[j].w * v[j].w); }
        const float rstd = __builtin_amdgcn_rsqf(wave_sum(ss) * (1.0f / DM) + EPS);
#pragma unroll
        for (int j = 0; j < 4; ++j) { const int col = (lane + 64 * j) * 4; const f32x4 gg = *(const f32x4*)(g + col);
            *(f32x4*)(xr + col) = (v[j] * rstd) * gg; }
    }
}
__device__ __forceinline__ void mla_norm_phase(const bf16_t* PROJ, const float* gq, const float* gkv, bf16_t* CQN, bf16_t* CKVN, bf16_t* KR, int gw, int NGW, int lane) {
    const int pidx = lane & 31;
    const float invf = __builtin_amdgcn_exp2f(-(float)(pidx & 15) * (LOG2_THETA / 16.0f));
    for (int row = gw; row < MT; row += NGW) {
        const bf16_t* pr = PROJ + (size_t)row * 768;
        unsigned q[3]; float ss = 0.f;
#pragma unroll
        for (int i = 0; i < 3; ++i) { q[i] = *(const unsigned*)(pr + lane * 2 + 128 * i); const float a = bflo(q[i]), b = bfhi(q[i]); ss += a * a + b * b; }
        const u32x2v kv = *(const u32x2v*)(pr + 384 + lane * 4);
        const float k0 = bflo(kv.x), k1 = bfhi(kv.x), k2 = bflo(kv.y), k3 = bfhi(kv.y);
        float s2 = (k0 * k0 + k1 * k1) + (k2 * k2 + k3 * k3);
        const float xr = bf2f(pr[640 + lane]);
        const float rq = __builtin_amdgcn_rsqf(wave_sum(ss) * (1.0f / 384.0f) + EPS);
        const float rkv = __builtin_amdgcn_rsqf(wave_sum(s2) * (1.0f / 256.0f) + EPS);
#pragma unroll
        for (int i = 0; i < 3; ++i) { const int col = lane * 2 + 128 * i;
            *(unsigned*)(CQN + (size_t)row * 384 + col) = pk2(bflo(q[i]) * rq * gq[col], bfhi(q[i]) * rq * gq[col + 1]); }
        { const int col = lane * 4; const f32x4 gg = *(const f32x4*)(gkv + col);
          u32x2v w; w.x = pk2(k0 * rkv * gg.x, k1 * rkv * gg.y); w.y = pk2(k2 * rkv * gg.z, k3 * rkv * gg.w);
          *(u32x2v*)(CKVN + (size_t)row * 256 + col) = w; }
        float outv = xr;
        const float other = __shfl_xor(xr, 32);
        if (row < ML) { const int t = row & 4095; const float pos = (float)(pidx < 16 ? (t >> 6) : (t & 63)); const float ang = pos * invf;
            const float cs = __cosf(ang), sn = __sinf(ang);
            outv = lane < 32 ? (xr * cs - other * sn) : (xr * cs + other * sn); }
        KR[(size_t)row * 64 + lane] = (bf16_t)f2bf(outv);
    }
}
__device__ __forceinline__ void mla_qrope_phase(bf16_t* Q, int gw, int NGW, int lane) {
    const int head = lane >> 3, sub = lane & 7;
    float invf[4];
#pragma unroll
    for (int i = 0; i < 4; ++i) invf[i] = __builtin_amdgcn_exp2f(-(float)((sub * 4 + i) & 15) * (LOG2_THETA / 16.0f));
    for (int row = gw; row < ML; row += NGW) {
        bf16_t* qp = Q + (size_t)row * 1536 + head * 192 + 128 + sub * 4;
        const u32x2v a = *(const u32x2v*)qp, b = *(const u32x2v*)(qp + 32);
        const float x1[4] = {bflo(a.x), bfhi(a.x), bflo(a.y), bfhi(a.y)}, x2[4] = {bflo(b.x), bfhi(b.x), bflo(b.y), bfhi(b.y)};
        const int t = row & 4095; const float pos = (float)(sub < 4 ? (t >> 6) : (t & 63));
        float o1[4], o2[4];
#pragma unroll
        for (int i = 0; i < 4; ++i) { const float ang = pos * invf[i]; const float cs = __cosf(ang), sn = __sinf(ang);
            o1[i] = x1[i] * cs - x2[i] * sn; o2[i] = x2[i] * cs + x1[i] * sn; }
        u32x2v w1, w2; w1.x = pk2(o1[0], o1[1]); w1.y = pk2(o1[2], o1[3]); w2.x = pk2(o2[0], o2[1]); w2.y = pk2(o2[2], o2[3]);
        *(u32x2v*)qp = w1; *(u32x2v*)(qp + 32) = w2;
    }
}
__device__ __forceinline__ void gqa_normrope_phase(bf16_t* PROJ, const float* gq, const float* gk, int gw, int NGW, int lane) {
    const float invf = __builtin_amdgcn_exp2f(-(float)(lane & 31) * (LOG2_THETA / 32.0f));
    for (int row = gw; row < MT; row += NGW) {
        bf16_t* pr = PROJ + (size_t)row * 1536;
        const bool lat = row < ML; const int t = row & 4095; const float pos = (float)(lane < 32 ? (t >> 6) : (t & 63));
        const float ang = pos * invf; const float cs = lat ? __cosf(ang) : 1.0f, sn = lat ? __sinf(ang) : 0.0f;
#pragma unroll 2
        for (int hh = 0; hh < 10; ++hh) {
            bf16_t* hp = pr + hh * 128; const float* g = hh < 8 ? gq : gk;
            const float x1 = bf2f(hp[lane]), x2 = bf2f(hp[64 + lane]);
            const float rstd = __builtin_amdgcn_rsqf(wave_sum(x1 * x1 + x2 * x2) * (1.0f / 128.0f) + EPS);
            const float y1 = x1 * rstd * g[lane], y2 = x2 * rstd * g[64 + lane];
            hp[lane] = (bf16_t)f2bf(y1 * cs - y2 * sn); hp[64 + lane] = (bf16_t)f2bf(y2 * cs + y1 * sn);
        }
    }
}

__device__ __forceinline__ void attn_phase(int kind, const KP& p, int jm, char* lds, int G) {
    unsigned char* ws = p.ws; bf16_t* XN = (bf16_t*)(ws + WS_XN);
    const int bid = blockIdx.x;
#if AEN & 1
    if (kind == 0) {
        const bf16_t* Q = (const bf16_t*)(ws + WS_TMP + T_AQ); const bf16_t* KV = (const bf16_t*)(ws + WS_TMP + T_AKV); const bf16_t* KR = (const bf16_t*)(ws + WS_TMP + T_AKR);
        const int nlat = 1024, ntot = nlat + 64;
        for (int uidx = bid; uidx < ntot; uidx += G) {
            att::AUnit u; int b, h; size_t qrow;
            if (uidx < nlat) { const int rnd = uidx / G, xcd = bid & 7, slot = bid >> 3; const int pair = rnd * 16 + xcd * 2 + (slot >> 4); b = pair >> 3; h = pair & 7; qrow = (size_t)b * SEQ + (size_t)(slot & 15) * 256; u.nt = 68; }
            else { const int c = uidx - nlat; b = c >> 3; h = c & 7; qrow = (size_t)ML + (size_t)b * CTXL; u.nt = 4; }
            const size_t crow0 = (size_t)ML + (size_t)b * CTXL, lrow0 = (size_t)b * SEQ;
            u.q = Q + qrow * 1536 + h * 192;
            u.k1c = KV + crow0 * 2048 + h * 256; u.k1l = KV + lrow0 * 2048 + h * 256;
            u.k2c = KR + crow0 * 64; u.k2l = KR + lrow0 * 64;
            u.vc = u.k1c + 128; u.vl = u.k1l + 128;
            u.o = XN + qrow * 1024 + h * 128; u.nctx = 4; u.C = 0.07216878364870322f * 1.4426950408889634f;
            u.R0 = 0; u.klo = 0; u.rpb = nullptr;
            att::attn_unit<192, 128, 0, 1, 1536, 2048, 64, 2048, 1024>(u, lds);
        }
    }
#endif
#if AEN & 2
    if (kind == 1) {
        const bf16_t* PR = (const bf16_t*)(ws + WS_TMP + T_PROJ);
        const int nlat = 1024, ntot = nlat + 64;
        for (int uidx = bid; uidx < ntot; uidx += G) {
            att::AUnit u; int b, h; size_t qrow;
            if (uidx < nlat) { const int rnd = uidx / G, xcd = bid & 7, slot = bid >> 3; const int pair = rnd * 16 + xcd * 2 + (slot >> 4); b = pair >> 3; h = pair & 7; qrow = (size_t)b * SEQ + (size_t)(slot & 15) * 256; u.nt = 68; }
            else { const int c = uidx - nlat; b = c >> 3; h = c & 7; qrow = (size_t)ML + (size_t)b * CTXL; u.nt = 4; }
            const int kvh = h >> 2;
            const size_t crow0 = (size_t)ML + (size_t)b * CTXL, lrow0 = (size_t)b * SEQ;
            u.q = PR + qrow * 1536 + h * 128;
            u.k1c = PR + crow0 * 1536 + 1024 + kvh * 128; u.k1l = PR + lrow0 * 1536 + 1024 + kvh * 128;
            u.k2c = nullptr; u.k2l = nullptr;
            u.vc = u.k1c + 256; u.vl = u.k1l + 256;
            u.o = XN + qrow * 1024 + h * 128; u.nctx = 4; u.C = 0.08838834764831845f * 1.4426950408889634f;
            u.R0 = 0; u.klo = 0; u.rpb = nullptr;
            att::attn_unit<128, 128, 0, 2, 1536, 1536, 64, 1536, 1024>(u, lds);
        }
    }
#endif
#if AEN & 4
    if (kind == 2) {
        const bf16_t* PR = (const bf16_t*)(ws + WS_TMP + T_PROJ);
        const float* rpb = p.in[22] + (size_t)jm * 16 * 15 * 31;
        const int nlat = 2048, ntot = nlat + 128;
        for (int uidx = bid; uidx < ntot; uidx += G) {
            att::AUnit u; int b, h; size_t qrow; u.R0 = 0; u.klo = 0;
            if (uidx < nlat) { const int rnd = uidx / G, xcd = bid & 7, slot = bid >> 3; const int pair = rnd * 16 + xcd * 2 + (slot >> 4); b = pair >> 4; h = pair & 15;
                const int R0 = (slot & 15) * 4; qrow = (size_t)b * SEQ + (size_t)R0 * 64;
                int klo = R0 - 4; klo = klo < 0 ? 0 : (klo > 56 ? 56 : klo);
                int khi = R0 - 1; khi = khi < 0 ? 0 : (khi > 56 ? 56 : khi); khi += 7;
                if (((khi - klo + 1) & 1) != 0) { if (khi < 63) ++khi; else --klo; }
                u.R0 = R0; u.klo = klo; u.nt = 4 + (khi - klo + 1); }
            else { const int c = uidx - nlat; b = c >> 4; h = c & 15; qrow = (size_t)ML + (size_t)b * CTXL; u.nt = 4; }
            const size_t crow0 = (size_t)ML + (size_t)b * CTXL, lrow0 = (size_t)b * SEQ + (size_t)u.klo * 64;
            u.q = PR + qrow * 3072 + h * 64;
            u.k1c = PR + crow0 * 3072 + 1024 + h * 64; u.k1l = PR + lrow0 * 3072 + 1024 + h * 64;
            u.k2c = nullptr; u.k2l = nullptr;
            u.vc = u.k1c + 1024; u.vl = u.k1l + 1024;
            u.o = XN + qrow * 1024 + h * 64; u.nctx = 4; u.C = 0.125f * 1.4426950408889634f;
            u.rpb = rpb + (size_t)h * 15 * 31;
            att::attn_unit<64, 64, 1, 2, 3072, 3072, 64, 3072, 1024>(u, lds);
        }
    }
#endif
}

#define XB_TMO      128
#define XB_XCNT(j)  (256  + 64 * (j))
#define XB_XSUB(j)  (1280 + 64 * (j))
#define XB_XGEN(j)  (2304 + 64 * (j))
#define XB_TOP      3328
#define XB_TOPGEN   3392
#define XCD_BAR_WORDS 3456
#define XB_SPIN_CAP (1u << 18)

__device__ __forceinline__ unsigned xb_ld(unsigned* p)              { return __hip_atomic_load(p, __ATOMIC_RELAXED, __HIP_MEMORY_SCOPE_AGENT); }
__device__ __forceinline__ unsigned xb_add(unsigned* p, unsigned v) { return __hip_atomic_fetch_add(p, v, __ATOMIC_RELAXED, __HIP_MEMORY_SCOPE_AGENT); }
__device__ __forceinline__ unsigned xb_xcc_id() { return (unsigned)__builtin_amdgcn_s_getreg((3 << 11) | 20) & 0xFu; }
#define XB_SPIN(cond, bar) do { unsigned _sp = 0; while (cond) { __builtin_amdgcn_s_sleep(1); \
    if ((++_sp & 255u) == 0u) { if (xb_ld(&(bar)[XB_TMO])) break; if (_sp > XB_SPIN_CAP) { atomicAdd(&(bar)[XB_TMO], 1u); break; } } } } while (0)

struct XcdBarrier {
    unsigned* bar; unsigned x;
    volatile LAS unsigned* st;
};

__device__ __forceinline__ XcdBarrier xcd_barrier_post(unsigned* bar, volatile LAS unsigned* st) {
    XcdBarrier b; b.bar = bar; b.x = xb_xcc_id(); b.st = st;
    if (threadIdx.x == 0) (void)xb_add(&bar[XB_XCNT(b.x)], 1u);
    return b;
}
__device__ __forceinline__ void xcd_barrier_complete(unsigned* bar, unsigned x, unsigned& nloc, unsigned& nx) {
    const unsigned G = gridDim.x * gridDim.y * gridDim.z;
    unsigned sum, cnt, mine, sp = 0u;
    for (;;) {
        sum = 0u; cnt = 0u; mine = 0u;
#pragma unroll
        for (unsigned j = 0; j < 16; ++j) { const unsigned c = xb_ld(&bar[XB_XCNT(j)]); sum += c; cnt += (c > 0u) ? 1u : 0u; mine = (j == x) ? c : mine; }
        if (sum == G) break;
        __builtin_amdgcn_s_sleep(1);
        if ((++sp & 255u) == 0u) { if (xb_ld(&bar[XB_TMO])) break; if (sp > XB_SPIN_CAP) { atomicAdd(&bar[XB_TMO], 1u); break; } }
    }
    nloc = mine > 0u ? mine : 1u; nx = cnt > 0u ? cnt : 1u;
}

__device__ __forceinline__ void xcd_barrier(const XcdBarrier& b) {
    asm volatile("s_waitcnt vmcnt(0)" ::: "memory");
    __syncthreads();
    if (threadIdx.x == 0) {
        unsigned* bar = b.bar;
        __builtin_amdgcn_s_waitcnt(0);
        unsigned nloc = b.st[0], nx = b.st[1];
        if (nloc == 0u) { xcd_barrier_complete(bar, b.x, nloc, nx); b.st[0] = nloc; b.st[1] = nx; }
        const unsigned old = xb_add(&bar[XB_XSUB(b.x)], 1u);
        const unsigned gen = old / nloc;
        if (old + 1u == (gen + 1u) * nloc) {
            __builtin_amdgcn_fence(__ATOMIC_RELEASE, "agent");
            asm volatile("s_waitcnt vmcnt(0)" ::: "memory");
            const unsigned og = xb_add(&bar[XB_TOP], 1u);
            const unsigned tg = og / nx;
            if (og + 1u == (tg + 1u) * nx) xb_add(&bar[XB_TOPGEN], 1u);
            else XB_SPIN(xb_ld(&bar[XB_TOPGEN]) == tg, bar);
            __builtin_amdgcn_fence(__ATOMIC_ACQUIRE, "agent");
            xb_add(&bar[XB_XGEN(b.x)], 1u);
            asm volatile("s_waitcnt vmcnt(0)" ::: "memory");
        } else {
            XB_SPIN(xb_ld(&bar[XB_XGEN(b.x)]) == gen, bar);
            __builtin_amdgcn_fence(__ATOMIC_ACQUIRE, "agent");
            asm volatile("s_waitcnt vmcnt(0)" ::: "memory");
        }
    }
    __syncthreads();
}

enum { T_SKIP = 0, T_NORM, T_UP, T_RES, T_PLAIN, T_ELT_A1, T_ELT_A2, T_ELT_B, T_ATTN };

__global__ void __launch_bounds__(512, 2) fwd_mega(KP p, int ph_lo, int ph_hi) {
    extern __shared__ __attribute__((aligned(16))) unsigned char lds_raw[];
    cg::grid_group grid = cg::this_grid();
    LAS unsigned char* lds = (LAS unsigned char*)lds_raw;
    const int G = gridDim.x, NGW = G * 8;
    unsigned char* ws = p.ws;
    bf16_t* Wb = (bf16_t*)(ws + WS_W); bf16_t* XN = (bf16_t*)(ws + WS_XN); float* XC = (float*)(ws + WS_XC); float* MOD = (float*)(ws + WS_MOD);
    unsigned char* tmp = ws + WS_TMP;
    int phase = 0, repc = 0;
    for (int u_ = threadIdx.x; u_ < (LDS_BYTES - 131072) / 4; u_ += 512) ((LAS unsigned*)(lds + 131072))[u_] = 0u;
    __syncthreads();
    (void)xcd_barrier_post((unsigned*)ws + 4096, (volatile LAS unsigned*)(lds + 131072 + 320) + 8);
#define SEAM() do { ++phase; if (phase > ph_lo && phase < ph_hi) { if (phase == 1) grid.sync(); else { XcdBarrier bar_; bar_.bar = (unsigned*)KARGS()->ws + 4096; bar_.x = xb_xcc_id(); bar_.st = (volatile LAS unsigned*)(lds + 131072 + 320) + 8; xcd_barrier(bar_); } } } while (0)
#define ACTIVE() (phase >= ph_lo && phase < ph_hi)
#if EN & 64
    for (int rep_ = 0; rep_ < REP_PRO; ++rep_) {
    if (ACTIVE()) { int tl_ = threadIdx.x; asm volatile("" : "+v"(tl_)); prologue_phase(p, lds, tl_, tl_ & 63, __builtin_amdgcn_readfirstlane(tl_ >> 6), G); }
    SEAM(); }
#else
    SEAM();
#endif
    for (int rep_ = 0; rep_ < REP_PRE; ++rep_) {
    if (ACTIVE()) { int tl_ = threadIdx.x; asm volatile("" : "+v"(tl_)); pre_phase(p, lds, tl_, tl_ & 63, __builtin_amdgcn_readfirstlane(tl_ >> 6), G); }
    SEAM(); }
    for (int l = 0; l < DEPTH; ++l) {
        const int kind = l % 3, jm = l / 3;
        const float* modl = MOD + (size_t)l * 9 * 9216;
        bf16_t* WL = Wb + (size_t)l * W_LAYER;
        for (int s = 0; s < 13; ++s) {
            int type;
            switch (s) {
            case 1: case 11: type = T_UP; break;
            case 2: case 9: case 12: type = T_RES; break;
            case 4: type = T_PLAIN; break;
            case 5: type = kind == 0 ? T_ELT_A1 : (kind == 1 ? T_ELT_B : T_SKIP); break;
            case 6: type = kind == 0 ? T_PLAIN : T_SKIP; break;
            case 7: type = kind == 0 ? T_ELT_A2 : T_SKIP; break;
            case 8: type = T_ATTN; break;
            default: type = T_SKIP; break;
            }
            if (type == T_SKIP) continue;
            if (ACTIVE()) {
                int tl_ = threadIdx.x; asm volatile("" : "+v"(tl_)); const int lane = tl_ & 63; const int gw = blockIdx.x * 8 + __builtin_amdgcn_readfirstlane(tl_ >> 6);
                switch (type) {
#if EN & 2
                case T_UP: { const int half = s == 1 ? 0 : 1;
                    pg8::Gemm g{half ? (const bf16_t*)(tmp + T_XG2) : XN, WL + (half ? W_13B : W_13A), MT, 2 * DFF, DM}; pg8::StaticOrder S; S.init(MT, 2 * DFF, G, (int)blockIdx.x, DM, 0);
                    pg8::EpiSwiglu E{l, half};
                    pg8::gemm_phase<pg8::EpiSwiglu, pg8::StaticOrder, true, true>(lds, g, S, E); } break;
#endif
#if EN & 4
                case T_RES: { const bf16_t* gA; const bf16_t* gB; int gK;
                    if (s == 9) { gA = XN; gK = 1024; gB = kind == 0 ? Wb + W_MX + (size_t)jm * W_ASZ + W_A_O : (kind == 1 ? Wb + W_MXB + W_B_O : Wb + W_MXC + W_C_O); }
                    else { gA = (const bf16_t*)(tmp + T_ACT); gK = DFF; gB = WL + (s == 2 ? W_2A : W_2B); }
                    pg8::Gemm g{gA, gB, MT, DM, gK}; pg8::StaticOrder S; S.init(MT, DM, G, (int)blockIdx.x, gK, 0);
                    pg8::EpiRes E{l, s};
                    pg8::gemm_phase<pg8::EpiRes, pg8::StaticOrder, true, true>(lds, g, S, E); } break;
#endif
#if EN & 8
                case T_PLAIN: {
                    const int ngem = s == 6 ? 2 : 1;
                    for (int gi = 0; gi < ngem; ++gi) {
                        const bf16_t* gA; const bf16_t* gB; int gN, gK; bf16_t* gO; int ssidx = -1;
                        if (s == 4) { gA = XN; gK = 1024; ssidx = l * 3 + 1;
                            if (kind == 0)      { gB = Wb + W_MX + (size_t)jm * W_ASZ + W_A_IN; gN = 768; gO = (bf16_t*)(tmp + T_APROJ); }
                            else if (kind == 1) { gB = Wb + W_MXB + W_B_QKV; gN = 1536; gO = (bf16_t*)(tmp + T_PROJ); }
                            else                { gB = Wb + W_MXC + W_C_QKV; gN = 3072; gO = (bf16_t*)(tmp + T_PROJ); } }
                        else if (gi == 0) { gA = (const bf16_t*)(tmp + T_ACQN); gB = Wb + W_MX + (size_t)jm * W_ASZ + W_A_UQ; gN = 1536; gK = 384; gO = (bf16_t*)(tmp + T_AQ); }
                        else { gA = (const bf16_t*)(tmp + T_ACKVN); gB = Wb + W_MX + (size_t)jm * W_ASZ + W_A_UKV; gN = 2048; gK = 256; gO = (bf16_t*)(tmp + T_AKV); }
                        pg8::Gemm g{gA, gB, MT, gN, gK}; pg8::StaticOrder S; S.init(MT, gN, G, (int)blockIdx.x, gK, 0);
                        pg8::EpiBf16N E{gO, gN, ssidx, l};
                        pg8::gemm_phase<pg8::EpiBf16N, pg8::StaticOrder, true, true>(lds, g, S, E);
                        __syncthreads();
                    } } break;
#endif
#if EN & 16
                case T_ELT_A1: mla_norm_phase((const bf16_t*)(tmp + T_APROJ), p.in[12] + (size_t)jm * 384, p.in[13] + (size_t)jm * 256,
                                              (bf16_t*)(tmp + T_ACQN), (bf16_t*)(tmp + T_ACKVN), (bf16_t*)(tmp + T_AKR), gw, NGW, lane); break;
                case T_ELT_A2: mla_qrope_phase((bf16_t*)(tmp + T_AQ), gw, NGW, lane); break;
                case T_ELT_B: gqa_normrope_phase((bf16_t*)(tmp + T_PROJ), p.in[18] + (size_t)jm * 128, p.in[19] + (size_t)jm * 128, gw, NGW, lane); break;
#endif
#if EN & 32
                case T_ATTN: attn_phase(kind, p, jm, (char*)lds_raw, G); break;
#endif
                default: break;
                }
            }
            SEAM();
            { const int nrep_ = (type == T_ATTN) ? REP_ATTN : (type == T_UP) ? REP_UP : (type == T_PLAIN) ? REP_PLAIN : (type == T_ELT_A1) ? REP_A1 : 1;
              if (repc + 1 < nrep_) { ++repc; --s; } else repc = 0; }
        }
    }
    for (int es_ = 0; es_ < EXTRA_SYNCS; ++es_) { XcdBarrier bar_; bar_.bar = (unsigned*)KARGS()->ws + 4096; bar_.x = xb_xcc_id(); bar_.st = (volatile LAS unsigned*)(lds + 131072 + 320) + 8; xcd_barrier(bar_); }
    if (ACTIVE()) { int tl_ = threadIdx.x; asm volatile("" : "+v"(tl_)); final_norm_phase(p.out, p.in[24], blockIdx.x * 8 + __builtin_amdgcn_readfirstlane(tl_ >> 6), NGW, tl_ & 63); }
#undef SEAM
#undef ACTIVE
}

extern "C" void kernel_launch(void* const* d_in, const int* in_sizes, int n_in, void* d_out, int out_size, void* d_ws, size_t ws_size, hipStream_t stream) {
    static int grid = 0;
    if (grid == 0) {
        if (n_in != 25 || out_size != ML * DM || ws_size < WS_END) { fprintf(stderr, "kernel_launch: unexpected shapes: n_in %d out %d ws %zu (need %zu)\n", n_in, out_size, ws_size, (size_t)WS_END); grid = -1; return; }
        int dev = 0, cus = 0, per_cu = 0;
        hipGetDevice(&dev); hipDeviceGetAttribute(&cus, hipDeviceAttributeMultiprocessorCount, dev);
        if (hipFuncSetAttribute((const void*)fwd_mega, hipFuncAttributeMaxDynamicSharedMemorySize, LDS_BYTES) != hipSuccess) { fprintf(stderr, "kernel_launch: hipFuncSetAttribute failed\n"); grid = -1; return; }
        if (hipOccupancyMaxActiveBlocksPerMultiprocessor(&per_cu, (const void*)fwd_mega, 512, LDS_BYTES) != hipSuccess || per_cu < 1) { fprintf(stderr, "kernel_launch: occupancy query says %d\n", per_cu); per_cu = 1; }
        (void)hipGetLastError();
        grid = cus;
        fprintf(stderr, "kernel_launch: grid %d (cus %d, per_cu %d)\n", grid, cus, per_cu);
    }
    if (grid < 0) return;
    KP p{};
    for (int i = 0; i < 25; ++i) p.in[i] = (const float*)d_in[i];
    p.out = (float*)d_out; p.ws = (unsigned char*)d_ws;
    if (hipMemsetAsync(d_ws, 0, 1u << 20, stream) != hipSuccess) { fprintf(stderr, "kernel_launch: hipMemsetAsync failed\n"); return; }
    int lo = 0, hi = 1 << 30;
    void* args[] = {&p, &lo, &hi};
    hipError_t e = hipLaunchCooperativeKernel((const void*)fwd_mega, dim3(grid), dim3(512), args, LDS_BYTES, stream);
    if (e != hipSuccess) fprintf(stderr, "cooperative launch failed: %s (grid %d)\n", hipGetErrorString(e), grid);
}
```

```cpp
#include <hip/hip_runtime.h>
#include <hip/hip_bf16.h>
#include <hip/hip_cooperative_groups.h>
#include <cstdio>
#include <cstdint>
namespace cg = cooperative_groups;
typedef unsigned short bf16_t;
constexpr int DM = 1024, NB = 8, SEQ = 4096, ML = NB * SEQ, CTXL = 256, MC = NB * CTXL, MT = ML + MC, DFF = 2816, DEPTH = 4;
constexpr float EPS = 1e-6f;
constexpr float LOG2_THETA = 13.287712379549449f;
constexpr size_t MiB = 1u << 20;
constexpr size_t WS_MOD = 1 * MiB, WS_SS = 3 * MiB, WS_GM = 5 * MiB, WS_SWUP = 6 * MiB, WS_SWPR = 8 * MiB, WS_XC = 9 * MiB, WS_W = 17 * MiB, WS_XN = 174 * MiB, WS_TMP = 242 * MiB, WS_END = 532 * MiB;
constexpr size_t T_XG2 = 188 * MiB;
constexpr size_t W_LAYER = 17301504, W_13A = 0, W_2A = 5767168, W_13B = 8650752, W_2B = 14417920;
constexpr size_t W_MX = 69206016, W_ASZ = 2949120, W_A_IN = 0, W_A_UQ = 786432, W_A_UKV = 1376256, W_A_O = 1900544;
constexpr size_t W_MXB = W_MX + 2 * W_ASZ, W_B_QKV = 0, W_B_O = 1572864;
constexpr size_t W_MXC = W_MXB + 2621440, W_C_QKV = 0, W_C_O = 3145728;
static_assert(W_MXC + 4194304 == 81920000 && WS_W + 81920000ull * 2 <= WS_XN, "weight map");
constexpr size_t T_ACT = 0;
constexpr size_t T_AQ = 0, T_ACQN = 102 * MiB, T_ACKVN = 128 * MiB, T_AKR = 146 * MiB, T_AKV = 152 * MiB, T_APROJ = 152 * MiB;
constexpr size_t T_PROJ = 0;
static_assert(WS_TMP + T_AKV + (size_t)MT * 2048 * 2 <= WS_END && WS_TMP + (size_t)MT * 3072 * 2 <= WS_END, "tmp map");
constexpr int LDS_BYTES = 147456;

struct KP { const float* in[25]; float* out; unsigned char* ws; };


#define KARGS() ({ const __attribute__((address_space(4))) KP* kp_ = (const __attribute__((address_space(4))) KP*)__builtin_amdgcn_kernarg_segment_ptr(); asm volatile("" : "+s"(kp_)); kp_; })
namespace pg8 {
#define PG8_LAS __attribute__((address_space(3)))
typedef unsigned short bf16_t;
typedef short bf16x8 __attribute__((ext_vector_type(8)));
typedef float f32x4 __attribute__((ext_vector_type(4)));
typedef unsigned u32x4 __attribute__((ext_vector_type(4)));
typedef unsigned u32x2 __attribute__((ext_vector_type(2)));
constexpr int BM = 256, BK = 64, HALF = 128, HTB = HALF * BK * 2  , STAGE_BYTES = 8 * HTB, NXCD = 8, WGM = 8;

__host__ __device__ __forceinline__ int lds_byte(int r, int c) { const int st = (r >> 4) * 2 + (c >> 5), rr = r & 15, cc = c & 31, ob = rr * 64 + cc * 2; return st * 1024 + (ob ^ (((ob >> 9) & 1) << 5)); }
__host__ __device__ __forceinline__ void stage_rc(int b, int& R, int& C) { const int st = b / 1024, sb = b % 1024, swz = sb ^ (((sb >> 9) & 1) << 5); R = (st >> 1) * 16 + swz / 64; C = (st & 1) * 32 + (swz % 64) / 2; }
__host__ __device__ __forceinline__ int perm32(int rho) { const int n = rho >> 4, i = rho & 15; return 8 * (i >> 2) + 4 * n + (i & 3); }

struct Unit { int pm, pn, kt0, nt, part; };
struct Gemm { const bf16_t* A; const bf16_t* Bt; int M, N, K; };

struct StaticOrder {
    int nM, nN, nwg, G, c, ntk, split;
    __host__ __device__ void init(int M, int N, int G_, int c_, int K_ = 0, int split_ = 0) { nM = M / BM; nN = N / BM; nwg = nM * nN; G = G_; c = c_; ntk = K_ / BK; split = split_; }
    __host__ __device__ void map(int wgid, Unit& u) const {
        { const int q = nwg / NXCD, r = nwg % NXCD, xcd = wgid % NXCD, off = wgid / NXCD; wgid = (xcd < r ? xcd * (q + 1) : r * (q + 1) + (xcd - r) * q) + off; }
        const int nig = WGM * nN, gid = wgid / nig, fm = gid * WGM, gsz = (nM - fm) < WGM ? (nM - fm) : WGM;
        u.pm = fm + ((wgid % nig) % gsz); u.pn = (wgid % nig) / gsz;
    }
    __host__ __device__ bool next(int i, Unit& u) const {
        const long L = (long)i * G + c;
        const int nfull = split ? (nwg / G) * G : nwg;
        if (L < nfull) { map((int)L, u); u.kt0 = 0; u.nt = ntk; u.part = 0; return true; }
        if (!split || i != nwg / G) return false;
        const int rem = nwg - nfull, ways = G / rem, j = c / ways, kp = c % ways;
        if (j >= rem) return false;
        const int P = ntk / 2, p0 = kp * P / ways, p1 = (kp + 1) * P / ways;
        if (p1 <= p0) return false;
        map(nfull + j, u); u.kt0 = 2 * p0; u.nt = 2 * (p1 - p0); u.part = 1; return true;
    }
    __device__ __forceinline__ void a_ready(const Unit&) const {}
    __device__ __forceinline__ void done(const Unit&) const {}
};

__device__ __forceinline__ unsigned cvt_pk_bf16(float lo, float hi) { unsigned r; asm volatile("v_cvt_pk_bf16_f32 %0, %1, %2" : "=v"(r) : "v"(lo), "v"(hi)); return r; }
typedef float f32x2 __attribute__((ext_vector_type(2)));
__device__ __forceinline__ f32x2 gelu_pk(f32x2 v) {
    const f32x2 av = __builtin_elementwise_abs(v), d = av * 0.2316418882f + 1.0f;
    f32x2 t; t.x = __builtin_amdgcn_rcpf(d.x); t.y = __builtin_amdgcn_rcpf(d.y);
    f32x2 q = t * 0.5307027145f + (-0.7265760135f); q = q * t + 0.7107068705f; q = q * t + (-0.142248368f); q = q * t + 0.127414796f; q = q * t;
    const f32x2 s = (v * v) * (-0.72134752044f);
    f32x2 e; e.x = __builtin_amdgcn_exp2f(s.x); e.y = __builtin_amdgcn_exp2f(s.y);
    const f32x2 m = v * (q * e), r = v - m;
    f32x2 o; o.x = v.x < 0.f ? m.x : r.x; o.y = v.y < 0.f ? m.y : r.y; return o;
}

template <int ACT  > struct EpiBf16 {
    static constexpr bool PERM = true, AFTER_DRAIN = false; static_assert(ACT == 0 || ACT == 1, "EpiBf16: ACT is 0 (none) or 1 (gelu_pk)");
    bf16_t* O; int ldc; const float* bias; int split_cols; size_t split_stride; float scale0;
    __device__ __forceinline__ void operator()(const f32x4 (&acc)[2][2][4][2], const Unit& u, int wr, int wc, int fr, int fq) const {
        const int row0 = u.pm * BM + wr * 64 + fr; int colt = u.pn * BM; bf16_t* base = O;
        float sc = 1.f; if (split_cols) { const int t = colt / split_cols; base += (size_t)t * split_stride; colt -= t * split_cols; if (t == 0) sc = scale0; }
        const int col0 = colt + wc * 32 + 8 * fq, bcol0 = u.pn * BM + wc * 32 + 8 * fq;
        f32x4 bv[2][2];
#pragma unroll
        for (int bj = 0; bj < 2; ++bj)
#pragma unroll
            for (int n = 0; n < 2; ++n) bv[bj][n] = bias ? *(const f32x4*)(bias + bcol0 + bj * HALF + 4 * n) : (f32x4){0.f, 0.f, 0.f, 0.f};
#pragma unroll
        for (int ai = 0; ai < 2; ++ai)
#pragma unroll
            for (int m = 0; m < 4; ++m) { bf16_t* rowp = base + (size_t)(row0 + ai * HALF + m * 16) * ldc + col0;
#pragma unroll
                for (int bj = 0; bj < 2; ++bj) { f32x4 v0 = acc[ai][bj][m][0] + bv[bj][0], v1 = acc[ai][bj][m][1] + bv[bj][1];
                    if (ACT == 1) { f32x2 a = gelu_pk((f32x2){v0[0], v0[1]}), b = gelu_pk((f32x2){v0[2], v0[3]}), c = gelu_pk((f32x2){v1[0], v1[1]}), d = gelu_pk((f32x2){v1[2], v1[3]});
                        v0 = (f32x4){a.x, a.y, b.x, b.y}; v1 = (f32x4){c.x, c.y, d.x, d.y}; }
                    v0 = v0 * sc; v1 = v1 * sc; u32x4 w; w.x = cvt_pk_bf16(v0[0], v0[1]); w.y = cvt_pk_bf16(v0[2], v0[3]); w.z = cvt_pk_bf16(v1[0], v1[1]); w.w = cvt_pk_bf16(v1[2], v1[3]);
                    *(u32x4*)(rowp + bj * HALF) = w; } }
    }
};

__device__ __forceinline__ float silu_f(float g) { return g * __builtin_amdgcn_rcpf(1.0f + __builtin_amdgcn_exp2f(-1.4426950408889634f * g)); }
constexpr float NEPS = 1e-6f;
struct EpiSwiglu {
    static constexpr bool PERM = true, AFTER_DRAIN = false;
    int l, half;
    __device__ __forceinline__ void operator()(const f32x4 (&acc)[2][2][4][2], const Unit& u, int wr, int wc, int fr, int fq) const {
        const auto kp = KARGS(); unsigned char* ws = kp->ws;
        bf16_t* O = (bf16_t*)(ws + WS_TMP + T_ACT); constexpr int ldc = DFF; const float* SS = (const float*)(ws + WS_SS) + (size_t)(l * 3 + (half ? 2 : 0)) * MT;
        const float* SW = (const float*)(ws + WS_SWUP) + (size_t)(l * 2 + half) * 9 * 5632;
        const int row0 = u.pm * BM + wr * 64 + fr; const int col0 = u.pn * HALF + wc * 32 + 8 * fq;
        const int mb = u.pm < 128 ? (u.pm >> 4) : 8;
        const float* swp = SW + (size_t)mb * 5632 + col0;
        const f32x4 sg0 = *(const f32x4*)swp, sg1 = *(const f32x4*)(swp + 4), su0 = *(const f32x4*)(swp + 2816), su1 = *(const f32x4*)(swp + 2820);
#pragma unroll
        for (int ai = 0; ai < 2; ++ai)
#pragma unroll
            for (int m = 0; m < 4; ++m) { const int row = row0 + ai * HALF + m * 16; bf16_t* rowp = O + (size_t)row * ldc + col0;
                const float rstd = __builtin_amdgcn_rsqf(SS[row] * (1.0f / 1024.0f) + NEPS);
                const f32x4 g0 = acc[ai][0][m][0] * rstd + sg0, g1 = acc[ai][0][m][1] * rstd + sg1, u0 = acc[ai][1][m][0] * rstd + su0, u1 = acc[ai][1][m][1] * rstd + su1;
                f32x4 v0, v1;
#pragma unroll
                for (int i = 0; i < 4; ++i) { v0[i] = silu_f(g0[i]) * u0[i]; v1[i] = silu_f(g1[i]) * u1[i]; }
                u32x4 w; w.x = cvt_pk_bf16(v0[0], v0[1]); w.y = cvt_pk_bf16(v0[2], v0[3]); w.z = cvt_pk_bf16(v1[0], v1[1]); w.w = cvt_pk_bf16(v1[2], v1[3]);
                *(u32x4*)rowp = w; }
    }
};
struct EpiBf16N {
    static constexpr bool PERM = true, AFTER_DRAIN = false;
    bf16_t* O; int ldc; int ssidx, l;
    __device__ __forceinline__ void operator()(const f32x4 (&acc)[2][2][4][2], const Unit& u, int wr, int wc, int fr, int fq) const {
        const auto kp = KARGS(); unsigned char* ws = kp->ws;
        const float* SS = ssidx >= 0 ? (const float*)(ws + WS_SS) + (size_t)ssidx * MT : nullptr; const float* SW = (const float*)(ws + WS_SWPR) + (size_t)l * 9 * 3072; constexpr int ldsw = 3072;
        const int row0 = u.pm * BM + wr * 64 + fr; const int col0 = u.pn * BM + wc * 32 + 8 * fq;
        const int mb = u.pm < 128 ? (u.pm >> 4) : 8;
        f32x4 bv[2][2];
#pragma unroll
        for (int bj = 0; bj < 2; ++bj)
#pragma unroll
            for (int n = 0; n < 2; ++n) bv[bj][n] = SS ? *(const f32x4*)(SW + (size_t)mb * ldsw + col0 + bj * HALF + 4 * n) : (f32x4){0.f, 0.f, 0.f, 0.f};
#pragma unroll
        for (int ai = 0; ai < 2; ++ai)
#pragma unroll
            for (int m = 0; m < 4; ++m) { const int row = row0 + ai * HALF + m * 16; bf16_t* rowp = O + (size_t)row * ldc + col0;
                const float rstd = SS ? __builtin_amdgcn_rsqf(SS[row] * (1.0f / 1024.0f) + NEPS) : 1.0f;
#pragma unroll
                for (int bj = 0; bj < 2; ++bj) { const f32x4 v0 = acc[ai][bj][m][0] * rstd + bv[bj][0], v1 = acc[ai][bj][m][1] * rstd + bv[bj][1];
                    u32x4 w; w.x = cvt_pk_bf16(v0[0], v0[1]); w.y = cvt_pk_bf16(v0[2], v0[3]); w.z = cvt_pk_bf16(v1[0], v1[1]); w.w = cvt_pk_bf16(v1[2], v1[3]);
                    *(u32x4*)(rowp + bj * HALF) = w; } }
    }
};
struct EpiRes {
    static constexpr bool PERM = true, AFTER_DRAIN = false;
    int l, s_in;
    __device__ __forceinline__ void operator()(const f32x4 (&acc)[2][2][4][2], const Unit& u, int wr, int wc, int fr, int fq) const {
        const auto kp = KARGS(); unsigned char* ws = kp->ws;
        const bool skipn = (s_in & 16) != 0; const int s = s_in & 15;
        const bool first = (l == 0 && s == 2);
        float* dstL = kp->out; float* dstC = (float*)(ws + WS_XC);
        const float* srcL = first ? kp->in[0] : dstL; const float* srcC = first ? kp->in[2] : dstC;
        const float* gate = (const float*)(ws + WS_MOD) + (size_t)l * 9 * 9216 + (s == 2 ? 2 : (s == 9 ? 5 : 8)) * 1024; const float f = s == 9 ? 1.0f : 0.5f;
        const int nxt = s == 2 ? l * 3 + 1 : (s == 9 ? l * 3 + 2 : l * 3 + 3);
        const float* gm = (nxt < 12 && !skipn) ? (const float*)(ws + WS_GM) + (size_t)nxt * 9 * 1024 : nullptr;
        bf16_t* XG = s == 9 ? (bf16_t*)(ws + WS_TMP + T_XG2) : (bf16_t*)(ws + WS_XN); float* SS = (float*)(ws + WS_SS) + (size_t)(nxt < 12 ? nxt : 0) * MT;
        const int pm = u.pm; const int mb = pm < 128 ? (pm >> 4) : 8;
        const float* src = pm < 128 ? srcL + (size_t)pm * 256 * 1024 : srcC + (size_t)(pm - 128) * 256 * 1024;
        float* dst = pm < 128 ? dstL + (size_t)pm * 256 * 1024 : dstC + (size_t)(pm - 128) * 256 * 1024;
        const float* gp = gate + (size_t)mb * 9216;
        const int col0 = u.pn * BM + wc * 32 + 8 * fq;
        f32x4 gv[2][2], gmv[2][2];
#pragma unroll
        for (int bj = 0; bj < 2; ++bj)
#pragma unroll
            for (int n = 0; n < 2; ++n) { gv[bj][n] = *(const f32x4*)(gp + col0 + bj * HALF + n * 4) * f;
                gmv[bj][n] = gm ? *(const f32x4*)(gm + (size_t)mb * 1024 + col0 + bj * HALF + n * 4) : (f32x4){0.f, 0.f, 0.f, 0.f}; }
#pragma unroll
        for (int ai = 0; ai < 2; ++ai)
#pragma unroll
            for (int m = 0; m < 4; ++m) { const int r = ai * HALF + wr * 64 + m * 16 + fr; const size_t off = (size_t)r * 1024 + col0; float ss = 0.f;
#pragma unroll
                for (int bj = 0; bj < 2; ++bj) {
                    const f32x4 b0 = *(const f32x4*)(src + off + bj * HALF), b1 = *(const f32x4*)(src + off + bj * HALF + 4);
                    const f32x4 o0 = b0 + gv[bj][0] * acc[ai][bj][m][0], o1 = b1 + gv[bj][1] * acc[ai][bj][m][1];
                    *(f32x4*)(dst + off + bj * HALF) = o0; *(f32x4*)(dst + off + bj * HALF + 4) = o1;
                    if (gm) { ss += ((o0[0] * o0[0] + o0[1] * o0[1]) + (o0[2] * o0[2] + o0[3] * o0[3])) + ((o1[0] * o1[0] + o1[1] * o1[1]) + (o1[2] * o1[2] + o1[3] * o1[3]));
                        const f32x4 x0 = o0 * gmv[bj][0], x1 = o1 * gmv[bj][1];
                        u32x4 w; w.x = cvt_pk_bf16(x0[0], x0[1]); w.y = cvt_pk_bf16(x0[2], x0[3]); w.z = cvt_pk_bf16(x1[0], x1[1]); w.w = cvt_pk_bf16(x1[2], x1[3]);
                        *(u32x4*)(XG + (size_t)pm * 256 * 1024 + off + bj * HALF) = w; } }
                if (gm) { ss += __shfl_xor(ss, 16); ss += __shfl_xor(ss, 32);
                    if (fq == 0) __hip_atomic_fetch_add(SS + pm * 256 + r, ss, __ATOMIC_RELAXED, __HIP_MEMORY_SCOPE_AGENT); } }
    }
};
template <class Epi, class Sched, bool ALIGN_EPI = false, bool SP2 = false>
__device__ __forceinline__ void gemm_phase(PG8_LAS unsigned char* lds, const Gemm g, const Sched& S, const Epi& E) {
    int tid_ = threadIdx.x; asm volatile("" : "+v"(tid_)); const int tid = tid_, wid = __builtin_amdgcn_readfirstlane(tid >> 6), lane = tid & 63, wr = wid >> 2, wc = wid & 3, fr = lane & 15, fq = lane >> 4;
    const int K = g.K;
    unsigned voffA[2], voffB[2];
#pragma unroll
    for (int i = 0; i < 2; ++i) { int R, C; stage_rc(tid * 16 + i * 8192, R, C); const int Rb = Epi::PERM ? ((R & ~31) + perm32(R & 31)) : R;
        voffA[i] = (unsigned)(R * K + C) * 2u; voffB[i] = (unsigned)(Rb * K + C) * 2u; }
    const size_t kstep = (size_t)(BK * 2);
    const size_t hstep = (size_t)HALF * K * 2;
    const size_t tstep = 2 * hstep;
    const unsigned ldsw = (unsigned)wid * 1024u;
    const int aoff = lds_byte(wr * 64 + fr, fq * 8), boff = lds_byte(wc * 32 + fr, fq * 8);
#define PG8_SA(b, h) (((b) * 2 + (h)) * HTB)
#define PG8_SB(b, h) ((4 + (b) * 2 + (h)) * HTB)
#define PG8_STAGE(bufoff, gbase, voff) do { _Pragma("unroll") for (int _i = 0; _i < 2; ++_i) \
        __builtin_amdgcn_global_load_lds((const unsigned*)((const char*)(gbase) + (voff)[_i]), (PG8_LAS unsigned*)(lds + (bufoff) + ldsw + _i * 8192), 16, 0, 0); } while (0)
#define PG8_LDA(dst, b, h) do { _Pragma("unroll") for (int m = 0; m < 4; ++m) _Pragma("unroll") for (int k = 0; k < 2; ++k) dst[m][k] = *(const PG8_LAS bf16x8*)(lds + PG8_SA(b, h) + aoff + m * 2048 + k * 1024); } while (0)
#define PG8_LDB(dst, b, h) do { _Pragma("unroll") for (int n = 0; n < 2; ++n) _Pragma("unroll") for (int k = 0; k < 2; ++k) dst[n][k] = *(const PG8_LAS bf16x8*)(lds + PG8_SB(b, h) + boff + n * 2048 + k * 1024); } while (0)
#define PG8_MMA(ai, bj, At, Bt) do { __builtin_amdgcn_s_setprio(1); _Pragma("unroll") for (int m = 0; m < 4; ++m) _Pragma("unroll") for (int n = 0; n < 2; ++n) _Pragma("unroll") for (int k = 0; k < 2; ++k) \
        acc[ai][bj][m][n] = __builtin_amdgcn_mfma_f32_16x16x32_bf16(Bt[n][k], At[m][k], acc[ai][bj][m][n], 0, 0, 0); __builtin_amdgcn_s_setprio(0); } while (0)
#define PG8_WAIT_V(n) asm volatile("s_waitcnt vmcnt(" #n ")" ::: "memory")
#define PG8_WAIT_L(n) asm volatile("s_waitcnt lgkmcnt(" #n ")" ::: "memory")
#define PG8_BAR __builtin_amdgcn_s_barrier()
#define PG8_SCHED __builtin_amdgcn_sched_barrier(0)
    Unit cur, nxt; int ui = 0;
    if (!S.next(0, cur)) return;
    f32x4 acc[2][2][4][2];
#pragma unroll
    for (int a = 0; a < 2; ++a)
#pragma unroll
        for (int b = 0; b < 2; ++b)
#pragma unroll
            for (int m = 0; m < 4; ++m)
#pragma unroll
                for (int n = 0; n < 2; ++n) acc[a][b][m][n] = (f32x4){0.f, 0.f, 0.f, 0.f};
    bf16x8 At[4][2], B0[2][2], B1[2][2];
    const char* cA = (const char*)g.A + (size_t)cur.pm * tstep + (size_t)cur.kt0 * kstep; const char* cB = (const char*)g.Bt + (size_t)cur.pn * tstep + (size_t)cur.kt0 * kstep;
    S.a_ready(cur);
    if constexpr (SP2) {
        PG8_STAGE(PG8_SB(0, 0), cB, voffB); PG8_STAGE(PG8_SB(0, 1), cB + hstep, voffB); PG8_STAGE(PG8_SA(0, 0), cA, voffA); PG8_STAGE(PG8_SA(0, 1), cA + hstep, voffA);
        if (wr == 1) PG8_BAR;
        PG8_WAIT_V(2); PG8_BAR;
        PG8_STAGE(PG8_SB(1, 0), cB + kstep, voffB); PG8_STAGE(PG8_SA(1, 0), cA + kstep, voffA); PG8_STAGE(PG8_SB(1, 1), cB + hstep + kstep, voffB);
        PG8_WAIT_V(6); PG8_BAR;
    } else {
        PG8_STAGE(PG8_SB(0, 0), cB, voffB); PG8_STAGE(PG8_SA(0, 0), cA, voffA); PG8_STAGE(PG8_SB(0, 1), cB + hstep, voffB); PG8_STAGE(PG8_SA(0, 1), cA + hstep, voffA);
        if (wr == 1) PG8_BAR;
        PG8_WAIT_V(4); PG8_BAR;
        PG8_STAGE(PG8_SB(1, 0), cB + kstep, voffB); PG8_STAGE(PG8_SA(1, 0), cA + kstep, voffA); PG8_STAGE(PG8_SB(1, 1), cB + hstep + kstep, voffB);
        PG8_WAIT_V(6); PG8_BAR;
    }
    for (;;) {
        const bool has_next = S.next(ui + 1, nxt);
        const char* nA = has_next ? (const char*)g.A + (size_t)nxt.pm * tstep + (size_t)nxt.kt0 * kstep : cA; const char* nB = has_next ? (const char*)g.Bt + (size_t)nxt.pn * tstep + (size_t)nxt.kt0 * kstep : cB;
        const int nt = cur.nt;
        for (int t = 0; t < nt; t += 2) {
            const bool last = (t == nt - 2);
            const char* a1 = cA + (size_t)(t + 1) * kstep;
            const char* a2 = last ? nA : cA + (size_t)(t + 2) * kstep; const char* b2 = last ? nB : cB + (size_t)(t + 2) * kstep;
            const char* a3 = a2 + kstep; const char* b3 = b2 + kstep;
            if (last && has_next) S.a_ready(nxt);
            if constexpr (SP2) {
            PG8_LDB(B0, 0, 0); PG8_LDB(B1, 0, 1); PG8_SCHED; PG8_LDA(At, 0, 0); PG8_STAGE(PG8_SA(1, 1), a1 + hstep, voffA);
            PG8_WAIT_V(8); PG8_WAIT_L(0); PG8_BAR; PG8_MMA(0, 0, At, B0); PG8_MMA(0, 1, At, B1); PG8_BAR; PG8_SCHED;
            PG8_LDA(At, 0, 1); PG8_STAGE(PG8_SB(0, 0), b2, voffB); PG8_STAGE(PG8_SB(0, 1), b2 + hstep, voffB); PG8_STAGE(PG8_SA(0, 0), a2, voffA);
            PG8_WAIT_V(8); PG8_WAIT_L(0); PG8_BAR; PG8_MMA(1, 0, At, B0); PG8_MMA(1, 1, At, B1); PG8_BAR; PG8_SCHED;
            PG8_LDB(B0, 1, 0); PG8_LDB(B1, 1, 1); PG8_SCHED; PG8_LDA(At, 1, 0); PG8_STAGE(PG8_SA(0, 1), a2 + hstep, voffA);
            PG8_WAIT_V(8); PG8_WAIT_L(0); PG8_BAR; PG8_MMA(0, 0, At, B0); PG8_MMA(0, 1, At, B1); PG8_BAR; PG8_SCHED;
            PG8_LDA(At, 1, 1); PG8_STAGE(PG8_SB(1, 0), b3, voffB); PG8_STAGE(PG8_SB(1, 1), b3 + hstep, voffB); PG8_STAGE(PG8_SA(1, 0), a3, voffA);
            PG8_WAIT_V(8); PG8_WAIT_L(0); PG8_BAR; PG8_MMA(1, 0, At, B0); PG8_MMA(1, 1, At, B1); PG8_BAR; PG8_SCHED;
            } else {
            PG8_LDB(B0, 0, 0); PG8_SCHED; PG8_LDA(At, 0, 0); PG8_STAGE(PG8_SA(1, 1), a1 + hstep, voffA);
            PG8_WAIT_L(8); PG8_BAR; PG8_WAIT_L(0); PG8_MMA(0, 0, At, B0); PG8_BAR; PG8_SCHED;
            PG8_LDB(B1, 0, 1); PG8_STAGE(PG8_SB(0, 0), b2, voffB);
            PG8_BAR; PG8_WAIT_L(0); PG8_MMA(0, 1, At, B1); PG8_BAR;
            PG8_LDA(At, 0, 1); PG8_STAGE(PG8_SA(0, 0), a2, voffA);
            PG8_BAR; PG8_WAIT_L(0); PG8_MMA(1, 0, At, B0); PG8_BAR; PG8_SCHED;
            PG8_STAGE(PG8_SB(0, 1), b2 + hstep, voffB);
            PG8_WAIT_V(6); PG8_BAR; PG8_MMA(1, 1, At, B1); PG8_BAR;
            PG8_LDB(B0, 1, 0); PG8_SCHED; PG8_LDA(At, 1, 0); PG8_STAGE(PG8_SA(0, 1), a2 + hstep, voffA);
            PG8_WAIT_L(8); PG8_BAR; PG8_WAIT_L(0); PG8_MMA(0, 0, At, B0); PG8_BAR; PG8_SCHED;
            PG8_LDB(B1, 1, 1); PG8_STAGE(PG8_SB(1, 0), b3, voffB);
            PG8_BAR; PG8_WAIT_L(0); PG8_MMA(0, 1, At, B1); PG8_BAR;
            PG8_LDA(At, 1, 1); PG8_STAGE(PG8_SA(1, 0), a3, voffA);
            PG8_BAR; PG8_WAIT_L(0); PG8_MMA(1, 0, At, B0); PG8_BAR; PG8_SCHED;
            PG8_STAGE(PG8_SB(1, 1), b3 + hstep, voffB);
            PG8_WAIT_V(6); PG8_BAR; PG8_MMA(1, 1, At, B1); PG8_BAR;
            }
        }
        if constexpr (ALIGN_EPI) { if (wr == 0) PG8_BAR; }
        if constexpr (!Epi::AFTER_DRAIN) { E(acc, cur, wr, wc, fr, fq); S.done(cur); }
        if (!has_next) break;
#pragma unroll
        for (int a = 0; a < 2; ++a)
#pragma unroll
            for (int b = 0; b < 2; ++b)
#pragma unroll
                for (int m = 0; m < 4; ++m)
#pragma unroll
                    for (int n = 0; n < 2; ++n) acc[a][b][m][n] = (f32x4){0.f, 0.f, 0.f, 0.f};
        cur = nxt; cA = nA; cB = nB; ++ui;
        if constexpr (ALIGN_EPI) { if (wr == 1) PG8_BAR; }
    }
    PG8_WAIT_V(0);
    if constexpr (!ALIGN_EPI) { if (wr == 0) PG8_BAR; }
    PG8_BAR;
    if constexpr (Epi::AFTER_DRAIN) { E.fused(acc, cur, wr, wc, fr, fq, lds, wid, lane); S.done(cur); }
#undef PG8_SA
#undef PG8_SB
#undef PG8_STAGE
#undef PG8_LDA
#undef PG8_LDB
#undef PG8_MMA
#undef PG8_WAIT_V
#undef PG8_WAIT_L
#undef PG8_BAR
#undef PG8_SCHED
}
}

namespace att {
typedef unsigned short bf16_t;
using bf16x8 = __attribute__((ext_vector_type(8))) short;
using s16x4  = __attribute__((ext_vector_type(4))) short;
using f32x16 = __attribute__((ext_vector_type(16))) float;
using u32x4  = __attribute__((ext_vector_type(4))) unsigned;
#define SBAR() __builtin_amdgcn_sched_barrier(0)
__device__ __forceinline__ int crow(int r, int hi) { return (r & 3) + 8 * (r >> 2) + 4 * hi; }
__device__ __forceinline__ unsigned cvtpk(float lo, float hi) { unsigned r; asm volatile("v_cvt_pk_bf16_f32 %0, %1, %2" : "=v"(r) : "v"(lo), "v"(hi)); return r; }
__device__ __forceinline__ bf16x8 ld8(const bf16_t* p) { return *reinterpret_cast<const bf16x8*>(p); }
__device__ __forceinline__ unsigned short f2bf1(float f) { unsigned u = __builtin_bit_cast(unsigned, f); return (unsigned short)((u + 0x7fffu + ((u >> 16) & 1u)) >> 16); }

struct AUnit {
  const bf16_t* q;
  const bf16_t* k1c; const bf16_t* k1l;
  const bf16_t* k2c; const bf16_t* k2l;
  const bf16_t* vc; const bf16_t* vl;
  bf16_t* o;
  int nt, nctx; float C;
  int rope, qpos0;
  int R0, klo; const float* rpb;
};

__device__ __forceinline__ void partialSM(f32x16& p0, f32x16& p1, float& m_reg, float& mn, float& alpha, const float C, const float thr) {
  float pmax = p0[0];
#pragma unroll
  for (int r = 1; r < 16; ++r) pmax = fmaxf(pmax, p0[r]);
#pragma unroll
  for (int r = 0; r < 16; ++r) pmax = fmaxf(pmax, p1[r]);
  { auto rr = __builtin_amdgcn_permlane32_swap(__float_as_uint(pmax), __float_as_uint(pmax), false, false);
    pmax = fmaxf(__uint_as_float(rr[0]), __uint_as_float(rr[1])); }
  if (__builtin_expect(__all(pmax - m_reg <= thr), 1)) { mn = m_reg; alpha = 1.f; }
  else { mn = fmaxf(m_reg, pmax); alpha = __builtin_amdgcn_exp2f((m_reg - mn) * C); m_reg = mn; }
  float mnC = -mn * C;
#pragma unroll
  for (int r = 0; r < 16; ++r) p0[r] = fmaf(p0[r], C, mnC);
#pragma unroll
  for (int r = 0; r < 16; ++r) p1[r] = fmaf(p1[r], C, mnC);
#pragma unroll
  for (int r = 0; r < 16; ++r) p0[r] = __builtin_amdgcn_exp2f(p0[r]);
}
__device__ __forceinline__ void finishSM(f32x16& p0, f32x16& p1, float alpha, float& l_reg, bf16x8& pa0, bf16x8& pa1, bf16x8& pa2, bf16x8& pa3) {
#pragma unroll
  for (int r = 0; r < 16; ++r) p1[r] = __builtin_amdgcn_exp2f(p1[r]);
  float ps = 0;
#pragma unroll
  for (int r = 0; r < 16; ++r) ps += p0[r];
#pragma unroll
  for (int r = 0; r < 16; ++r) ps += p1[r];
  { auto rr = __builtin_amdgcn_permlane32_swap(__float_as_uint(ps), __float_as_uint(ps), false, false);
    ps = __uint_as_float(rr[0]) + __uint_as_float(rr[1]); }
  l_reg = l_reg * alpha + ps;
#define PK4(P, BASE, OUT) do { unsigned a0 = cvtpk(P[BASE + 0], P[BASE + 1]), a1 = cvtpk(P[BASE + 2], P[BASE + 3]);   \
    unsigned b0 = cvtpk(P[BASE + 4], P[BASE + 5]), b1 = cvtpk(P[BASE + 6], P[BASE + 7]);                              \
    auto r0 = __builtin_amdgcn_permlane32_swap(a0, b0, false, false); auto r1 = __builtin_amdgcn_permlane32_swap(a1, b1, false, false); \
    u32x4 w = {r0[0], r1[0], r0[1], r1[1]}; OUT = *reinterpret_cast<bf16x8*>(&w); } while (0)
  PK4(p0, 0, pa0); PK4(p0, 8, pa1); PK4(p1, 0, pa2); PK4(p1, 8, pa3);
#undef PK4
}
template <int DK> __device__ __forceinline__ int kswz(int row, int colB) { return row * (DK * 2) + (colB ^ ((row & 7) << 4)); }
template <int DK> __device__ __forceinline__ void qkt(f32x16& p0, f32x16& p1, const char* Ks, const bf16x8* qr, const char* qlds, int r32, int hi) {
  p0 = f32x16{}; p1 = f32x16{};
#pragma unroll
  for (int d0 = 0; d0 < DK / 16; ++d0) { int cb = (d0 * 16 + hi * 8) * 2;
    bf16x8 b0 = *reinterpret_cast<const bf16x8*>(Ks + kswz<DK>(r32, cb));
    bf16x8 b1 = *reinterpret_cast<const bf16x8*>(Ks + kswz<DK>(32 + r32, cb));
    bf16x8 qf;
    if (DK == 192 && d0 >= 8) qf = *reinterpret_cast<const bf16x8*>(qlds + (d0 - 8) * 1024); else qf = qr[d0 < 8 ? d0 : 0];
    p0 = __builtin_amdgcn_mfma_f32_32x32x16_bf16(b0, qf, p0, 0, 0, 0);
    p1 = __builtin_amdgcn_mfma_f32_32x32x16_bf16(b1, qf, p1, 0, 0, 0); }
}
template <int DV> __device__ __forceinline__ int v_st(int k, int c) { const int kk = (k & ~0xC) | ((k & 4) << 1) | ((k & 8) >> 1); return ((kk >> 3) * (DV / 32) + (c >> 5)) * 512 + ((kk & 7) * 32 + (c & 31)) * 2; }
__device__ __forceinline__ int v_rd_base(int lane) { return ((lane & 3) << 3) | (((lane >> 2) & 3) << 6) | (((lane >> 4) & 1) << 5) | (((lane >> 5) & 1) << 8); }
template <int DV> constexpr int v_rd_off(int d0, int ks, int half) { return d0 * 512 + ks * (2 * (DV / 32) * 512) + half * ((DV / 32) * 512); }
template <int OFF> __device__ __forceinline__ s16x4 tr_read(int vb) {
  s16x4 r; asm volatile("ds_read_b64_tr_b16 %0, %1 offset:%2" : "=&v"(r) : "v"(vb), "i"(OFF) : "memory"); return r;
}
template <int D0, int DV> __device__ __forceinline__ void pv_one(f32x16& od, int vb, bf16x8 pa0, bf16x8 pa1, bf16x8 pa2, bf16x8 pa3) {
  const s16x4 l0 = tr_read<v_rd_off<DV>(D0, 0, 0)>(vb), h0 = tr_read<v_rd_off<DV>(D0, 0, 1)>(vb), l1 = tr_read<v_rd_off<DV>(D0, 1, 0)>(vb), h1 = tr_read<v_rd_off<DV>(D0, 1, 1)>(vb);
  const s16x4 l2 = tr_read<v_rd_off<DV>(D0, 2, 0)>(vb), h2 = tr_read<v_rd_off<DV>(D0, 2, 1)>(vb), l3 = tr_read<v_rd_off<DV>(D0, 3, 0)>(vb), h3 = tr_read<v_rd_off<DV>(D0, 3, 1)>(vb);
  asm volatile("s_waitcnt lgkmcnt(0)" ::: "memory"); SBAR();
#define PK(L, H) (bf16x8){L[0], L[1], L[2], L[3], H[0], H[1], H[2], H[3]}
  od = __builtin_amdgcn_mfma_f32_32x32x16_bf16(pa0, PK(l0, h0), od, 0, 0, 0);
  od = __builtin_amdgcn_mfma_f32_32x32x16_bf16(pa1, PK(l1, h1), od, 0, 0, 0);
  od = __builtin_amdgcn_mfma_f32_32x32x16_bf16(pa2, PK(l2, h2), od, 0, 0, 0);
  od = __builtin_amdgcn_mfma_f32_32x32x16_bf16(pa3, PK(l3, h3), od, 0, 0, 0);
#undef PK
}
template <int DV> __device__ __forceinline__ void pv_all(f32x16* o, int vb, bf16x8 pa0, bf16x8 pa1, bf16x8 pa2, bf16x8 pa3) {
  pv_one<0, DV>(o[0], vb, pa0, pa1, pa2, pa3); pv_one<1, DV>(o[1], vb, pa0, pa1, pa2, pa3);
  if constexpr (DV == 128) { pv_one<2, DV>(o[2], vb, pa0, pa1, pa2, pa3); pv_one<3, DV>(o[3], vb, pa0, pa1, pa2, pa3); }
}
__device__ __forceinline__ void nb_mask(f32x16& p0, f32x16& p1, bool rowok, int tbase, int cs, int hi, const float* T) {
#pragma unroll
  for (int r = 0; r < 16; ++r) { const int kc = crow(r, hi);
    const bool in0 = rowok && kc >= cs && kc < cs + 16; const float b0 = T[tbase + kc]; p0[r] = in0 ? p0[r] + b0 : -1e30f;
    const int kc1 = kc + 32;
    const bool in1 = rowok && kc1 >= cs && kc1 < cs + 16; const float b1 = T[tbase + kc1]; p1[r] = in1 ? p1[r] + b1 : -1e30f; }
}

template <int DK, int DV> constexpr int attn_lds_bytes() { return 2 * 64 * DV * 2 + 2 * 64 * DK * 2 + 2048 + 15 * 128 * 4; }

template <int DK, int DV, int MODE, int SD, int LDQ, int LDK1, int LDK2, int LDV, int LDO>
__device__ __forceinline__ void attn_unit(const AUnit& u, char* lds) {
  constexpr int KBYT = 64 * DK * 2, VBYT = 64 * DV * 2, ND = DK / 16, NO = DV / 32;
  constexpr int OFF_WS = 2 * VBYT + 2 * KBYT, OFF_T = OFF_WS + 2048, OFF_Q = OFF_T + 15 * 128 * 4, NDR = ND > 8 ? 8 : ND;
  constexpr int NLD = (DK == 192 ? 3 : (DK == 128 ? 2 : 1)) + (DV == 128 ? 2 : 1);
  int tid_ = threadIdx.x; asm volatile("" : "+v"(tid_)); const int tid = tid_, wid = __builtin_amdgcn_readfirstlane(tid >> 6), lane = tid & 63, r32 = lane & 31, hi = lane >> 5;
  char* V_lds = lds; char* K_lds = lds + 2 * VBYT;
  float* wsf = (float*)(lds + OFF_WS) + wid * 64; float* li_l = wsf; float* al_l = wsf + 32;
  float* T = (float*)(lds + OFF_T);
  __syncthreads();
  int qrow = 0, qcol = 0, r0w = 0, cs = 0;
  if constexpr (MODE == 1) {
    if (u.nt > u.nctx) { for (int e = tid; e < 15 * 128; e += 512) { const int ro = e >> 7, d = (e & 127) - 64; T[e] = (d >= -15 && d <= 15) ? 8.0f * u.rpb[ro * 31 + d + 15] : 0.f; } }
    qrow = u.R0 + (wid >> 1); qcol = (wid & 1) * 32 + r32;
    r0w = qrow - 4; r0w = r0w < 0 ? 0 : (r0w > 56 ? 56 : r0w);
    cs = qcol - 8; cs = cs < 0 ? 0 : (cs > 48 ? 48 : cs);
  }
  const float C = u.C, thr = 8.0f * 1.4426950408889634f / C;
  float m_reg = -1e30f, l_reg = 0; f32x16 o[NO] = {}; bf16x8 qr[NDR];
  char* qlds = lds + OFF_Q + wid * 4096 + lane * 16;
  const bf16_t* Qw = u.q + (unsigned)((wid * 32 + r32) * LDQ + hi * 8);
#pragma unroll
  for (int d0 = 0; d0 < NDR; ++d0) qr[d0] = ld8(Qw + d0 * 16);
  if constexpr (DK == 192) {
    bf16x8 f0 = ld8(Qw + 8 * 16), f1 = ld8(Qw + 9 * 16), f2 = ld8(Qw + 10 * 16), f3 = ld8(Qw + 11 * 16);
    if (u.rope) { const int t = u.qpos0 + wid * 32 + r32; const float pr = (float)(t >> 6), pc = (float)(t & 63);
#pragma unroll
      for (int e = 0; e < 8; ++e) { const float invf = __builtin_amdgcn_exp2f(-(float)(8 * hi + e) * (13.287712379549449f / 16.0f));
        { const float ang = pr * invf, cs = __cosf(ang), sn = __sinf(ang); const float x1 = __builtin_bit_cast(float, (unsigned)(unsigned short)f0[e] << 16), x2 = __builtin_bit_cast(float, (unsigned)(unsigned short)f2[e] << 16);
          f0[e] = (short)f2bf1(x1 * cs - x2 * sn); f2[e] = (short)f2bf1(x2 * cs + x1 * sn); }
        { const float ang = pc * invf, cs = __cosf(ang), sn = __sinf(ang); const float x1 = __builtin_bit_cast(float, (unsigned)(unsigned short)f1[e] << 16), x2 = __builtin_bit_cast(float, (unsigned)(unsigned short)f3[e] << 16);
          f1[e] = (short)f2bf1(x1 * cs - x2 * sn); f3[e] = (short)f2bf1(x2 * cs + x1 * sn); } } }
    *reinterpret_cast<bf16x8*>(qlds) = f0; *reinterpret_cast<bf16x8*>(qlds + 1024) = f1; *reinterpret_cast<bf16x8*>(qlds + 2048) = f2; *reinterpret_cast<bf16x8*>(qlds + 3072) = f3; }
  const int sr = tid >> 4, sc = (tid & 15) * 8, sr6 = tid >> 3, sc6 = (tid & 7) * 8;
  const unsigned kof = (DK >= 128 ? (unsigned)(sr * LDK1 + sc) : (unsigned)(sr6 * LDK1 + sc6)) * 2u, k2of = (unsigned)(sr6 * LDK2 + sc6) * 2u, vof = (DV == 128 ? (unsigned)(sr * LDV + sc) : (unsigned)(sr6 * LDV + sc6)) * 2u;
  const int vb0 = (int)(uintptr_t)V_lds + v_rd_base(lane);
  struct { bf16x8 k0, k1, k2, v0, v1; } st[SD];
#define TILEP(bc, bl, ld, j) ((const char*)((j) < u.nctx ? (bc) + (long)(j) * 64 * (ld) : (bl) + (long)((j) - u.nctx) * 64 * (ld)))
#define LDB(base, off) (*reinterpret_cast<const bf16x8*>((base) + (off)))
#define SLOAD(i, j) do { const char* kp_ = TILEP(u.k1c, u.k1l, LDK1, j); const char* vp_ = TILEP(u.vc, u.vl, LDV, j); \
    if constexpr (DK >= 128) { st[i].k0 = LDB(kp_, kof); st[i].k1 = LDB(kp_ + 32 * LDK1 * 2, kof); } \
    if constexpr (DK == 192) { const char* k2_ = TILEP(u.k2c, u.k2l, LDK2, j); st[i].k2 = LDB(k2_, k2of); } \
    if constexpr (DK == 64) { st[i].k0 = LDB(kp_, kof); } \
    if constexpr (DV == 128) { st[i].v0 = LDB(vp_, vof); st[i].v1 = LDB(vp_ + 32 * LDV * 2, vof); } \
    else { st[i].v0 = LDB(vp_, vof); } } while (0)
#define SWRITE(b, i) do { \
    if constexpr (DV == 128) { *(bf16x8*)(V_lds + (b) * VBYT + v_st<DV>(sr, sc)) = st[i].v0; *(bf16x8*)(V_lds + (b) * VBYT + v_st<DV>(32 + sr, sc)) = st[i].v1; } \
    else { *(bf16x8*)(V_lds + (b) * VBYT + v_st<DV>(sr6, sc6)) = st[i].v0; } \
    if constexpr (DK >= 128) { *(bf16x8*)(K_lds + (b) * KBYT + kswz<DK>(sr, sc * 2)) = st[i].k0; *(bf16x8*)(K_lds + (b) * KBYT + kswz<DK>(32 + sr, sc * 2)) = st[i].k1; } \
    if constexpr (DK == 192) { *(bf16x8*)(K_lds + (b) * KBYT + kswz<DK>(sr6, 256 + sc6 * 2)) = st[i].k2; } \
    if constexpr (DK == 64) { *(bf16x8*)(K_lds + (b) * KBYT + kswz<DK>(sr6, sc6 * 2)) = st[i].k0; } } while (0)
#define SWAIT() do { if constexpr (SD == 2 && NLD == 4) asm volatile("s_waitcnt vmcnt(4)" ::: "memory"); else if constexpr (SD == 2 && NLD == 2) asm volatile("s_waitcnt vmcnt(2)" ::: "memory"); \
    else asm volatile("s_waitcnt vmcnt(0)" ::: "memory"); } while (0)
#define RESC(a) do { if (__any((a) < 1.f)) { if (hi == 0) al_l[r32] = (a); asm volatile("s_waitcnt lgkmcnt(0)" ::: "memory"); \
    _Pragma("unroll") for (int d = 0; d < NO; ++d) _Pragma("unroll") for (int r = 0; r < 16; ++r) o[d][r] *= al_l[crow(r, hi)]; } } while (0)
#define MASK(P0, P1, j) do { if constexpr (MODE == 1) { if ((j) >= u.nctx) { const int krow_ = u.klo + (j) - u.nctx; const bool rowok_ = krow_ >= r0w && krow_ < r0w + 8; \
    int dr_ = krow_ - qrow + 7; dr_ = dr_ < 0 ? 0 : (dr_ > 14 ? 14 : dr_); nb_mask(P0, P1, rowok_, dr_ * 128 + 64 - qcol, cs, hi, T); } } } while (0)
  f32x16 pA0, pA1, pB0, pB1; float mnA, mnB, alA, alB; bf16x8 pa0, pa1, pa2, pa3; const int NT = u.nt;
  constexpr int SE = 0, SO = SD - 1;
  SLOAD(SE, 0); asm volatile("s_waitcnt vmcnt(0)" ::: "memory"); SWRITE(0, SE); __syncthreads();
  qkt<DK>(pA0, pA1, K_lds, qr, qlds, r32, hi); MASK(pA0, pA1, 0); partialSM(pA0, pA1, m_reg, mnA, alA, C, thr);
  SLOAD(SO, 1); if constexpr (SD == 2) { if (2 < NT) SLOAD(SE, 2); }
  SWAIT(); SWRITE(1, SO); __syncthreads();
  for (int j = 1; j + 1 < NT; j += 2) {
    SBAR(); qkt<DK>(pB0, pB1, K_lds + KBYT, qr, qlds, r32, hi); MASK(pB0, pB1, j);
    finishSM(pA0, pA1, alA, l_reg, pa0, pa1, pa2, pa3); SBAR();
    SLOAD(SO, j + SD); SBAR();
    pv_all<DV>(o, vb0, pa0, pa1, pa2, pa3); partialSM(pB0, pB1, m_reg, mnB, alB, C, thr);
    __syncthreads(); SWAIT(); SWRITE(0, SE);
    RESC(alB); __syncthreads();
    SBAR(); qkt<DK>(pA0, pA1, K_lds, qr, qlds, r32, hi); MASK(pA0, pA1, j + 1);
    finishSM(pB0, pB1, alB, l_reg, pa0, pa1, pa2, pa3); SBAR();
    if (SD == 1 || j + 3 < NT) SLOAD(SE, j + 1 + SD); SBAR();
    pv_all<DV>(o, vb0 + VBYT, pa0, pa1, pa2, pa3); partialSM(pA0, pA1, m_reg, mnA, alA, C, thr);
    __syncthreads(); SWAIT(); SWRITE(1, SO);
    RESC(alA); __syncthreads();
  }
  SBAR(); qkt<DK>(pB0, pB1, K_lds + KBYT, qr, qlds, r32, hi); MASK(pB0, pB1, NT - 1);
  finishSM(pA0, pA1, alA, l_reg, pa0, pa1, pa2, pa3); SBAR();
  pv_all<DV>(o, vb0, pa0, pa1, pa2, pa3); partialSM(pB0, pB1, m_reg, mnB, alB, C, thr);
  __syncthreads(); RESC(alB);
  finishSM(pB0, pB1, alB, l_reg, pa0, pa1, pa2, pa3); SBAR();
  pv_all<DV>(o, vb0 + VBYT, pa0, pa1, pa2, pa3);
  if (hi == 0) li_l[r32] = l_reg; asm volatile("s_waitcnt lgkmcnt(0)" ::: "memory");
  float rli[16];
#pragma unroll
  for (int r = 0; r < 16; ++r) rli[r] = __builtin_amdgcn_rcpf(li_l[crow(r, hi)]);
  bf16_t* Ow = u.o + (long)(wid * 32) * LDO;
#pragma unroll
  for (int r = 0; r < 16; ++r) { const int orow = crow(r, hi);
#pragma unroll
    for (int d0 = 0; d0 < NO; ++d0) Ow[orow * LDO + d0 * 32 + r32] = f2bf1(o[d0][r] * rli[r]); }
#undef TILEP
#undef LDB
#undef SLOAD
#undef SWRITE
#undef SWAIT
#undef RESC
#undef MASK
}
#undef SBAR
}
#ifndef EN
#define EN 127
#endif
#ifndef AEN
#define AEN 7
#endif
#ifndef REP_ATTN
#define REP_ATTN 1
#endif
#ifndef REP_UP
#define REP_UP 1
#endif
#ifndef REP_NORM
#define REP_NORM 1
#endif
#ifndef REP_PLAIN
#define REP_PLAIN 1
#endif
#ifndef EXTRA_SYNCS
#define EXTRA_SYNCS 0
#endif
#ifndef REP_RES0
#define REP_RES0 1
#endif
#ifndef REP_PRO
#define REP_PRO 1
#endif
#ifndef REP_PRE
#define REP_PRE 1
#endif
#ifndef REP_A1
#define REP_A1 1
#endif

#define LAS __attribute__((address_space(3)))
typedef float f32x4 __attribute__((ext_vector_type(4)));
typedef unsigned u32x4v __attribute__((ext_vector_type(4)));
typedef unsigned u32x2v __attribute__((ext_vector_type(2)));

__device__ __forceinline__ unsigned f2bf(float f) { unsigned u = __builtin_bit_cast(unsigned, f); return (u + 0x7fffu + ((u >> 16) & 1u)) >> 16; }
__device__ __forceinline__ unsigned pk2(float lo, float hi) { return f2bf(lo) | (f2bf(hi) << 16); }
__device__ __forceinline__ float bf2f(unsigned short b) { return __builtin_bit_cast(float, (unsigned)b << 16); }
__device__ __forceinline__ float bflo(unsigned w) { return __builtin_bit_cast(float, w << 16); }
__device__ __forceinline__ float bfhi(unsigned w) { return __builtin_bit_cast(float, w & 0xffff0000u); }
__device__ __forceinline__ float wave_sum(float v) {
#pragma unroll
    for (int o = 1; o < 64; o <<= 1) v += __shfl_xor(v, o);
    return v;
}
#define LDS_WAIT() asm volatile("s_waitcnt lgkmcnt(0)" ::: "memory")

__device__ __forceinline__ void transpose_item(const float* W, int K, int N, bf16_t* WT, int mode, LAS float* scr, int item, int lane) {
    const int nblk = N / 32, kb = item / nblk, nb = item % nblk, k0 = 64 * kb, n0 = 32 * nb;
    int drow0 = n0;
    if (mode == 1) drow0 = n0 < DFF ? ((n0 >> 7) * 256 + (n0 & 127)) : (((n0 - DFF) >> 7) * 256 + 128 + ((n0 - DFF) & 127));
#pragma unroll 8
    for (int i = 0; i < 32; ++i) { const int kk = 2 * i + (lane >> 5); scr[kk * 33 + (lane & 31)] = W[(size_t)(k0 + kk) * N + n0 + (lane & 31)]; }
    LDS_WAIT(); asm volatile("" ::: "memory");
    const int c = lane & 7;
#pragma unroll
    for (int j = 0; j < 4; ++j) { const int n = (lane >> 3) + 8 * j; const LAS float* s = scr + (8 * c) * 33 + n;
        u32x4v o; o.x = pk2(s[0 * 33], s[1 * 33]); o.y = pk2(s[2 * 33], s[3 * 33]); o.z = pk2(s[4 * 33], s[5 * 33]); o.w = pk2(s[6 * 33], s[7 * 33]);
        *(u32x4v*)(WT + (size_t)(drow0 + n) * K + k0 + 8 * c) = o; }
    LDS_WAIT(); asm volatile("" ::: "memory");
}
__device__ __forceinline__ void cvt_job(const KP& p, bf16_t* Wb, int job, const float*& src, int& K, int& N, bf16_t*& dst, int& mode) {
    mode = 0;
    if (job < 16) { const int l = job >> 2, t = job & 3; bf16_t* lb = Wb + (size_t)l * W_LAYER;
        if (t == 0)      { src = p.in[7]  + (size_t)l * 1024 * 5632; K = 1024; N = 5632; dst = lb + W_13A; mode = 1; }
        else if (t == 1) { src = p.in[8]  + (size_t)l * 2816 * 1024; K = 2816; N = 1024; dst = lb + W_2A; }
        else if (t == 2) { src = p.in[9]  + (size_t)l * 1024 * 5632; K = 1024; N = 5632; dst = lb + W_13B; mode = 1; }
        else             { src = p.in[10] + (size_t)l * 2816 * 1024; K = 2816; N = 1024; dst = lb + W_2B; }
    } else if (job < 24) { const int a = job - 16, j = a >> 2, t = a & 3; bf16_t* mb = Wb + W_MX + (size_t)j * W_ASZ;
        if (t == 0)      { src = p.in[11] + (size_t)j * 1024 * 704;  K = 1024; N = 704;  dst = mb + W_A_IN; }
        else if (t == 1) { src = p.in[14] + (size_t)j * 384 * 1536;  K = 384;  N = 1536; dst = mb + W_A_UQ; }
        else if (t == 2) { src = p.in[15] + (size_t)j * 256 * 2048;  K = 256;  N = 2048; dst = mb + W_A_UKV; }
        else             { src = p.in[16] + (size_t)j * 1024 * 1024; K = 1024; N = 1024; dst = mb + W_A_O; }
    } else if (job == 24) { src = p.in[17]; K = 1024; N = 1536; dst = Wb + W_MXB + W_B_QKV; }
    else if (job == 25)   { src = p.in[20]; K = 1024; N = 1024; dst = Wb + W_MXB + W_B_O; }
    else if (job == 26)   { src = p.in[21]; K = 1024; N = 3072; dst = Wb + W_MXC + W_C_QKV; }
    else                  { src = p.in[23]; K = 1024; N = 1024; dst = Wb + W_MXC + W_C_O; }
}
__device__ __forceinline__ void gemv9_item(LAS float* sv, LAS float* red, const float* W, int ldw, int N, int n0, const float* bias, float* out, int ldo, int tid) {
    const int cg4 = tid & 31, ks = tid >> 5;
    const bool cv = n0 + cg4 * 4 < N;
    const float* wp = W + (size_t)(ks * 64) * ldw + n0 + cg4 * 4;
    f32x4 acc[9];
#pragma unroll
    for (int j = 0; j < 9; ++j) acc[j] = (f32x4){0.f, 0.f, 0.f, 0.f};
    if (cv) {
#pragma unroll 4
        for (int k = 0; k < 64; ++k) { const f32x4 w = *(const f32x4*)(wp + (size_t)k * ldw);
#pragma unroll
            for (int j = 0; j < 9; ++j) acc[j] += w * sv[j * 1024 + ks * 64 + k]; }
    }
#pragma unroll
    for (int j = 0; j < 9; ++j) *(LAS f32x4*)(red + (ks * 9 + j) * 128 + cg4 * 4) = acc[j];
    __syncthreads();
    for (int e = tid; e < 9 * 128; e += 512) { const int j = e >> 7, cidx = e & 127;
        if (n0 + cidx < N) { float s = bias ? bias[n0 + cidx] : 0.f;
#pragma unroll
            for (int q = 0; q < 16; ++q) s += red[(q * 9 + j) * 128 + cidx];
            out[(size_t)j * ldo + n0 + cidx] = s; } }
    __syncthreads();
}
__device__ __forceinline__ void prologue_phase(const KP& p, LAS unsigned char* lds, int tid, int lane, int wave, int G) {
    bf16_t* Wb = (bf16_t*)(p.ws + WS_W);
    {
        LAS float* sv = (LAS float*)lds;
        LAS float* red = (LAS float*)(lds + 40960);
        const float* c = p.in[1]; const float* cc = p.in[3];
        for (int e = tid; e < 9 * 1024; e += 512) { const float x = e < 8192 ? c[e] : cc[e - 8192]; sv[e] = x / (1.0f + __expf(-x)); }
        __syncthreads();
        float* MOD = (float*)(p.ws + WS_MOD);
        for (int item = blockIdx.x; item < 288; item += G) {
            const int colg = item * 128, l = colg / 9216, n0 = colg % 9216;
            gemv9_item(sv, red, p.in[5] + (size_t)l * 1024 * 9216, 9216, 9216, n0, p.in[6] + (size_t)l * 9216, MOD + (size_t)l * 9 * 9216, 9216, tid);
        }
        float* SS = (float*)(p.ws + WS_SS);
        for (int e = blockIdx.x * 512 + tid; e < 12 * MT / 4; e += G * 512) *(f32x4*)(SS + (size_t)e * 4) = (f32x4){0.f, 0.f, 0.f, 0.f};
    }
    __syncthreads();
    {
        LAS float* scr = (LAS float*)(lds + wave * 16384);
        const int gw = blockIdx.x * 8 + wave, NGW = G * 8;
        int base = 0;
        for (int job = 0; job < 28; ++job) {
            const float* src; int K, N, mode; bf16_t* dst;
            cvt_job(p, Wb, job, src, K, N, dst, mode);
            const int nitems = (K / 64) * (N / 32);
            int first = gw - base; if (first < 0) first += NGW;
            for (int it = first; it < nitems; it += NGW) transpose_item(src, K, N, dst, mode, scr, it, lane);
            base = (base + nitems) % NGW;
        }
        for (int e = blockIdx.x * 512 + tid; e < 2 * 64 * 1024 / 8; e += G * 512) { const int j = e / 8192, r = e % 8192;
            *(u32x4v*)(Wb + W_MX + (size_t)j * W_ASZ + W_A_IN + (size_t)704 * 1024 + (size_t)r * 8) = (u32x4v){0u, 0u, 0u, 0u}; }
    }
}

__device__ __forceinline__ void pre_phase(const KP& p, LAS unsigned char* lds, int tid, int lane, int wave, int G) {
    const float* MOD = (const float*)(p.ws + WS_MOD);
    {
        LAS float* sv = (LAS float*)lds; LAS float* red = (LAS float*)(lds + 40960);
        float* SWUP = (float*)(p.ws + WS_SWUP); float* SWPR = (float*)(p.ws + WS_SWPR);
        for (int it = blockIdx.x; it < 400; it += G) {
            const float* W; int ldw, N, n0, l, chunk; float* out; int ldo;
            if (it < 352) { const int job = it / 44; l = job >> 1; const int half = job & 1; W = p.in[half ? 9 : 7] + (size_t)l * 1024 * 5632; ldw = 5632; N = 5632; n0 = (it % 44) * 128; chunk = half ? 6 : 0; out = SWUP + (size_t)job * 9 * 5632; ldo = 5632; }
            else { int r = it - 352; chunk = 3; ldo = 3072;
                if (r < 6) { l = 0; W = p.in[11]; N = 704; }
                else if (r < 18) { r -= 6; l = 1; W = p.in[17]; N = 1536; }
                else if (r < 42) { r -= 18; l = 2; W = p.in[21]; N = 3072; }
                else { r -= 42; l = 3; W = p.in[11] + (size_t)1024 * 704; N = 704; }
                ldw = N; n0 = r * 128; out = SWPR + (size_t)l * 9 * 3072; }
            for (int e = tid; e < 9 * 1024; e += 512) sv[e] = MOD[((size_t)l * 9 + (e >> 10)) * 9216 + chunk * 1024 + (e & 1023)];
            __syncthreads();
            gemv9_item(sv, red, W, ldw, N, n0, nullptr, out, ldo, tid);
        }
    }
    { float* GM = (float*)(p.ws + WS_GM);
      for (int e = blockIdx.x * 512 + tid; e < 12 * 9 * 1024; e += G * 512) { const int col = e & 1023, mb = (e >> 10) % 9, lw = (e >> 10) / 9, l = lw / 3, w = lw % 3;
          GM[e] = p.in[4][(size_t)lw * 1024 + col] * (1.0f + MOD[((size_t)l * 9 + mb) * 9216 + (3 * w + 1) * 1024 + col]); } }
    { const int gw = blockIdx.x * 8 + wave, NGW = G * 8; bf16_t* XN = (bf16_t*)(p.ws + WS_XN); float* SS = (float*)(p.ws + WS_SS);
      const float* g = p.in[4];
      for (int row = gw; row < MT; row += NGW) {
          const int mb = row < ML ? (row >> 12) : 8;
          const float* xr = row < ML ? p.in[0] + (size_t)row * DM : p.in[2] + (size_t)(row - ML) * DM;
          const float* sc = MOD + (size_t)mb * 9216 + 1024;
          float ss = 0.f;
#pragma unroll
          for (int j = 0; j < 4; ++j) { const int col = (lane + 64 * j) * 4; const f32x4 v = *(const f32x4*)(xr + col);
              ss += (v.x * v.x + v.y * v.y) + (v.z * v.z + v.w * v.w);
              const f32x4 y = v * (*(const f32x4*)(g + col)) * (*(const f32x4*)(sc + col) + 1.0f);
              u32x2v w; w.x = pk2(y.x, y.y); w.y = pk2(y.z, y.w);
              *(u32x2v*)(XN + (size_t)row * DM + col) = w; }
          ss = wave_sum(ss);
          if (lane == 0) SS[row] = ss;
      } }
}

__device__ __forceinline__ void norm_phase(const float* xL, const float* xC, const float* g, const float* shift, const float* scale, bf16_t* XN, int gw, int NGW, int lane) {
    for (int row = gw; row < MT; row += NGW) {
        const int mb = row < ML ? (row >> 12) : 8;
        const float* xr = row < ML ? xL + (size_t)row * DM : xC + (size_t)(row - ML) * DM;
        f32x4 v[4]; float ss = 0.f;
#pragma unroll
        for (int j = 0; j < 4; ++j) { v[j] = *(const f32x4*)(xr + (lane + 64 * j) * 4); ss += (v[j].x * v[j].x + v[j].y * v[j].y) + (v[j].z * v[j].z + v[j].w * v[j].w); }
        const float rstd = __builtin_amdgcn_rsqf(wave_sum(ss) * (1.0f / DM) + EPS);
        const float* sh = shift + (size_t)mb * 9216; const float* sc = scale + (size_t)mb * 9216;
#pragma unroll
        for (int j = 0; j < 4; ++j) { const int col = (lane + 64 * j) * 4;
            const f32x4 gg = *(const f32x4*)(g + col), s1 = *(const f32x4*)(sc + col), s0 = *(const f32x4*)(sh + col);
            const f32x4 y = (v[j] * rstd) * gg * (s1 + 1.0f) + s0;
            u32x2v w; w.x = pk2(y.x, y.y); w.y = pk2(y.z, y.w);
            *(u32x2v*)(XN + (size_t)row * DM + col) = w; }
    }
}
__device__ __forceinline__ void final_norm_phase(float* x, const float* g, int gw, int NGW, int lane) {
    for (int row = gw; row < ML; row += NGW) {
        float* xr = x + (size_t)row * DM;
        f32x4 v[4]; float ss = 0.f;
#pragma unroll
        for (int j = 0; j < 4; ++j) { v[j] = *(const f32x4*)(xr + (lane + 64 * j) * 4); ss += (v[j].x * v[j].x + v[j].y * v[j].y) + (v[j].z * v[j].z + v[j].w * v[j].w); }
        const float rstd = __builtin_amdgcn_rsqf(wave_sum(ss) * (1.0f / DM) + EPS);
#pragma unroll
        for (int j = 0; j < 4; ++j) { const int col = (lane + 64 * j) * 4; const f32x4 gg = *(const f32x4*)(g + col);
            *(f32x4*)(xr + col) = (v[j] * rstd) * gg; }
    }
}
__device__ __forceinline__ void mla_norm_phase(const bf16_t* PROJ, const float* gq, const float* gkv, bf16_t* CQN, bf16_t* CKVN, bf16_t* KR, int gw, int NGW, int lane) {
    const int pidx = lane & 31;
    const float invf = __builtin_amdgcn_exp2f(-(float)(pidx & 15) * (LOG2_THETA / 16.0f));
    for (int row = gw; row < MT; row += NGW) {
        const bf16_t* pr = PROJ + (size_t)row * 768;
        unsigned q[3]; float ss = 0.f;
#pragma unroll
        for (int i = 0; i < 3; ++i) { q[i] = *(const unsigned*)(pr + lane * 2 + 128 * i); const float a = bflo(q[i]), b = bfhi(q[i]); ss += a * a + b * b; }
        const u32x2v kv = *(const u32x2v*)(pr + 384 + lane * 4);
        const float k0 = bflo(kv.x), k1 = bfhi(kv.x), k2 = bflo(kv.y), k3 = bfhi(kv.y);
        float s2 = (k0 * k0 + k1 * k1) + (k2 * k2 + k3 * k3);
        const float xr = bf2f(pr[640 + lane]);
        const float rq = __builtin_amdgcn_rsqf(wave_sum(ss) * (1.0f / 384.0f) + EPS);
        const float rkv = __builtin_amdgcn_rsqf(wave_sum(s2) * (1.0f / 256.0f) + EPS);
#pragma unroll
        for (int i = 0; i < 3; ++i) { const int col = lane * 2 + 128 * i;
            *(unsigned*)(CQN + (size_t)row * 384 + col) = pk2(bflo(q[i]) * rq * gq[col], bfhi(q[i]) * rq * gq[col + 1]); }
        { const int col = lane * 4; const f32x4 gg = *(const f32x4*)(gkv + col);
          u32x2v w; w.x = pk2(k0 * rkv * gg.x, k1 * rkv * gg.y); w.y = pk2(k2 * rkv * gg.z, k3 * rkv * gg.w);
          *(u32x2v*)(CKVN + (size_t)row * 256 + col) = w; }
        float outv = xr;
        const float other = __shfl_xor(xr, 32);
        if (row < ML) { const int t = row & 4095; const float pos = (float)(pidx < 16 ? (t >> 6) : (t & 63)); const float ang = pos * invf;
            const float cs = __cosf(ang), sn = __sinf(ang);
            outv = lane < 32 ? (xr * cs - other * sn) : (xr * cs + other * sn); }
        KR[(size_t)row * 64 + lane] = (bf16_t)f2bf(outv);
    }
}
__device__ __forceinline__ void mla_qrope_phase(bf16_t* Q, int gw, int NGW, int lane) {
    const int head = lane >> 3, sub = lane & 7;
    float invf[4];
#pragma unroll
    for (int i = 0; i < 4; ++i) invf[i] = __builtin_amdgcn_exp2f(-(float)((sub * 4 + i) & 15) * (LOG2_THETA / 16.0f));
    for (int row = gw; row < ML; row += NGW) {
        bf16_t* qp = Q + (size_t)row * 1536 + head * 192 + 128 + sub * 4;
        const u32x2v a = *(const u32x2v*)qp, b = *(const u32x2v*)(qp + 32);
        const float x1[4] = {bflo(a.x), bfhi(a.x), bflo(a.y), bfhi(a.y)}, x2[4] = {bflo(b.x), bfhi(b.x), bflo(b.y), bfhi(b.y)};
        const int t = row & 4095; const float pos = (float)(sub < 4 ? (t >> 6) : (t & 63));
        float o1[4], o2[4];
#pragma unroll
        for (int i = 0; i < 4; ++i) { const float ang = pos * invf[i]; const float cs = __cosf(ang), sn = __sinf(ang);
            o1[i] = x1[i] * cs - x2[i] * sn; o2[i] = x2[i] * cs + x1[i] * sn; }
        u32x2v w1, w2; w1.x = pk2(o1[0], o1[1]); w1.y = pk2(o1[2], o1[3]); w2.x = pk2(o2[0], o2[1]); w2.y = pk2(o2[2], o2[3]);
        *(u32x2v*)qp = w1; *(u32x2v*)(qp + 32) = w2;
    }
}
__device__ __forceinline__ void gqa_normrope_phase(bf16_t* PROJ, const float* gq, const float* gk, int gw, int NGW, int lane) {
    const int hsel = lane >> 5, part = (lane >> 4) & 1, q = lane & 15, cofs = part * 64 + q * 4;
    const f32x4 gq4 = *(const f32x4*)(gq + cofs), gk4 = *(const f32x4*)(gk + cofs);
    float invf[4];
#pragma unroll
    for (int e = 0; e < 4; ++e) invf[e] = __builtin_amdgcn_exp2f(-(float)((q * 4 + e) & 31) * (LOG2_THETA / 32.0f));
    for (int row = gw; row < MT; row += NGW) {
        bf16_t* pr = PROJ + (size_t)row * 1536 + hsel * 128 + cofs;
        u32x2v raw[5];
#pragma unroll
        for (int i = 0; i < 5; ++i) raw[i] = *(const u32x2v*)(pr + i * 256);
        const bool lat = row < ML; const int t = row & 4095; const float pos = (float)(q < 8 ? (t >> 6) : (t & 63));
        float cs[4], sn[4];
#pragma unroll
        for (int e = 0; e < 4; ++e) { const float ang = pos * invf[e]; cs[e] = lat ? __cosf(ang) : 1.0f; sn[e] = lat ? __sinf(ang) : 0.0f; }
#pragma unroll
        for (int i = 0; i < 5; ++i) {
            float x[4] = {bflo(raw[i].x), bfhi(raw[i].x), bflo(raw[i].y), bfhi(raw[i].y)};
            float ss = (x[0] * x[0] + x[1] * x[1]) + (x[2] * x[2] + x[3] * x[3]);
#pragma unroll
            for (int o = 1; o < 32; o <<= 1) ss += __shfl_xor(ss, o);
            const float rstd = __builtin_amdgcn_rsqf(ss * (1.0f / 128.0f) + EPS);
            const f32x4 g4 = i < 4 ? gq4 : gk4;
            float y[4], ov[4];
#pragma unroll
            for (int e = 0; e < 4; ++e) y[e] = x[e] * rstd * g4[e];
#pragma unroll
            for (int e = 0; e < 4; ++e) { const float other = __shfl_xor(y[e], 16); ov[e] = part == 0 ? (y[e] * cs[e] - other * sn[e]) : (y[e] * cs[e] + other * sn[e]); }
            u32x2v w; w.x = pk2(ov[0], ov[1]); w.y = pk2(ov[2], ov[3]);
            *(u32x2v*)(pr + i * 256) = w;
        }
    }
}

__device__ __forceinline__ void attn_phase(int kind, const KP& p, int jm, char* lds, int G, bool ctx_out) {
    unsigned char* ws = p.ws; bf16_t* XN = (bf16_t*)(ws + WS_XN);
    const int bid = blockIdx.x;
#if AEN & 1
    if (kind == 0) {
        const bf16_t* Q = (const bf16_t*)(ws + WS_TMP + T_AQ); const bf16_t* KV = (const bf16_t*)(ws + WS_TMP + T_AKV); const bf16_t* KR = (const bf16_t*)(ws + WS_TMP + T_AKR);
        const int nlat = 1024, ntot = ctx_out ? nlat + 64 : nlat;
        for (int uidx = bid; uidx < ntot; uidx += G) {
            att::AUnit u; int b, h; size_t qrow;
            if (uidx < nlat) { const int rnd = uidx / G, xcd = bid & 7, slot = bid >> 3; const int pair = rnd * 16 + xcd * 2 + (slot >> 4); b = pair >> 3; h = pair & 7; qrow = (size_t)b * SEQ + (size_t)(slot & 15) * 256; u.nt = 68; }
            else { const int c = uidx - nlat; b = c >> 3; h = c & 7; qrow = (size_t)ML + (size_t)b * CTXL; u.nt = 4; }
            const size_t crow0 = (size_t)ML + (size_t)b * CTXL, lrow0 = (size_t)b * SEQ;
            u.q = Q + qrow * 1536 + h * 192;
            u.k1c = KV + crow0 * 2048 + h * 256; u.k1l = KV + lrow0 * 2048 + h * 256;
            u.k2c = KR + crow0 * 64; u.k2l = KR + lrow0 * 64;
            u.vc = u.k1c + 128; u.vl = u.k1l + 128;
            u.o = XN + qrow * 1024 + h * 128; u.nctx = 4; u.C = 0.07216878364870322f * 1.4426950408889634f;
            u.R0 = 0; u.klo = 0; u.rpb = nullptr; u.rope = uidx < nlat ? 1 : 0; u.qpos0 = (int)(qrow & 4095);
            att::attn_unit<192, 128, 0, 1, 1536, 2048, 64, 2048, 1024>(u, lds);
        }
    }
#endif
#if AEN & 2
    if (kind == 1) {
        const bf16_t* PR = (const bf16_t*)(ws + WS_TMP + T_PROJ);
        const int nlat = 1024, ntot = ctx_out ? nlat + 64 : nlat;
        for (int uidx = bid; uidx < ntot; uidx += G) {
            att::AUnit u; int b, h; size_t qrow;
            if (uidx < nlat) { const int rnd = uidx / G, xcd = bid & 7, slot = bid >> 3; const int pair = rnd * 16 + xcd * 2 + (slot >> 4); b = pair >> 3; h = pair & 7; qrow = (size_t)b * SEQ + (size_t)(slot & 15) * 256; u.nt = 68; }
            else { const int c = uidx - nlat; b = c >> 3; h = c & 7; qrow = (size_t)ML + (size_t)b * CTXL; u.nt = 4; }
            const int kvh = h >> 2;
            const size_t crow0 = (size_t)ML + (size_t)b * CTXL, lrow0 = (size_t)b * SEQ;
            u.q = PR + qrow * 1536 + h * 128;
            u.k1c = PR + crow0 * 1536 + 1024 + kvh * 128; u.k1l = PR + lrow0 * 1536 + 1024 + kvh * 128;
            u.k2c = nullptr; u.k2l = nullptr;
            u.vc = u.k1c + 256; u.vl = u.k1l + 256;
            u.o = XN + qrow * 1024 + h * 128; u.nctx = 4; u.C = 0.08838834764831845f * 1.4426950408889634f;
            u.R0 = 0; u.klo = 0; u.rpb = nullptr; u.rope = 0; u.qpos0 = 0;
            att::attn_unit<128, 128, 0, 2, 1536, 1536, 64, 1536, 1024>(u, lds);
        }
    }
#endif
#if AEN & 4
    if (kind == 2) {
        const bf16_t* PR = (const bf16_t*)(ws + WS_TMP + T_PROJ);
        const float* rpb = p.in[22] + (size_t)jm * 16 * 15 * 31;
        const int nlat = 2048, ntot = ctx_out ? nlat + 128 : nlat;
        for (int uidx = bid; uidx < ntot; uidx += G) {
            att::AUnit u; int b, h; size_t qrow; u.R0 = 0; u.klo = 0;
            if (uidx < nlat) { const int rnd = uidx / G, xcd = bid & 7, slot = bid >> 3; const int pair = rnd * 16 + xcd * 2 + (slot >> 4); b = pair >> 4; h = pair & 15;
                const int R0 = (slot & 15) * 4; qrow = (size_t)b * SEQ + (size_t)R0 * 64;
                int klo = R0 - 4; klo = klo < 0 ? 0 : (klo > 56 ? 56 : klo);
                int khi = R0 - 1; khi = khi < 0 ? 0 : (khi > 56 ? 56 : khi); khi += 7;
                if (((khi - klo + 1) & 1) != 0) { if (khi < 63) ++khi; else --klo; }
                u.R0 = R0; u.klo = klo; u.nt = 4 + (khi - klo + 1); }
            else { const int c = uidx - nlat; b = c >> 4; h = c & 15; qrow = (size_t)ML + (size_t)b * CTXL; u.nt = 4; }
            const size_t crow0 = (size_t)ML + (size_t)b * CTXL, lrow0 = (size_t)b * SEQ + (size_t)u.klo * 64;
            u.q = PR + qrow * 3072 + h * 64;
            u.k1c = PR + crow0 * 3072 + 1024 + h * 64; u.k1l = PR + lrow0 * 3072 + 1024 + h * 64;
            u.k2c = nullptr; u.k2l = nullptr;
            u.vc = u.k1c + 1024; u.vl = u.k1l + 1024;
            u.o = XN + qrow * 1024 + h * 64; u.nctx = 4; u.C = 0.125f * 1.4426950408889634f;
            u.rpb = rpb + (size_t)h * 15 * 31; u.rope = 0; u.qpos0 = 0;
            att::attn_unit<64, 64, 1, 2, 3072, 3072, 64, 3072, 1024>(u, lds);
        }
    }
#endif
}

#define XB_TMO      128
#define XB_XCNT(j)  (256  + 64 * (j))
#define XB_XSUB(j)  (1280 + 64 * (j))
#define XB_XGEN(j)  (2304 + 64 * (j))
#define XB_TOP      3328
#define XB_TOPGEN   3392
#define XCD_BAR_WORDS 3456
#define XB_SPIN_CAP (1u << 18)

__device__ __forceinline__ unsigned xb_ld(unsigned* p)              { return __hip_atomic_load(p, __ATOMIC_RELAXED, __HIP_MEMORY_SCOPE_AGENT); }
__device__ __forceinline__ unsigned xb_add(unsigned* p, unsigned v) { return __hip_atomic_fetch_add(p, v, __ATOMIC_RELAXED, __HIP_MEMORY_SCOPE_AGENT); }
__device__ __forceinline__ unsigned xb_xcc_id() { return (unsigned)__builtin_amdgcn_s_getreg((3 << 11) | 20) & 0xFu; }
#define XB_SPIN(cond, bar) do { unsigned _sp = 0; while (cond) { __builtin_amdgcn_s_sleep(1); \
    if ((++_sp & 255u) == 0u) { if (xb_ld(&(bar)[XB_TMO])) break; if (_sp > XB_SPIN_CAP) { atomicAdd(&(bar)[XB_TMO], 1u); break; } } } } while (0)

struct XcdBarrier {
    unsigned* bar; unsigned x;
    volatile LAS unsigned* st;
};

__device__ __forceinline__ XcdBarrier xcd_barrier_post(unsigned* bar, volatile LAS unsigned* st) {
    XcdBarrier b; b.bar = bar; b.x = xb_xcc_id(); b.st = st;
    if (threadIdx.x == 0) (void)xb_add(&bar[XB_XCNT(b.x)], 1u);
    return b;
}
__device__ __forceinline__ void xcd_barrier_complete(unsigned* bar, unsigned x, unsigned& nloc, unsigned& nx) {
    const unsigned G = gridDim.x * gridDim.y * gridDim.z;
    unsigned sum, cnt, mine, sp = 0u;
    for (;;) {
        sum = 0u; cnt = 0u; mine = 0u;
#pragma unroll
        for (unsigned j = 0; j < 16; ++j) { const unsigned c = xb_ld(&bar[XB_XCNT(j)]); sum += c; cnt += (c > 0u) ? 1u : 0u; mine = (j == x) ? c : mine; }
        if (sum == G) break;
        __builtin_amdgcn_s_sleep(1);
        if ((++sp & 255u) == 0u) { if (xb_ld(&bar[XB_TMO])) break; if (sp > XB_SPIN_CAP) { atomicAdd(&bar[XB_TMO], 1u); break; } }
    }
    nloc = mine > 0u ? mine : 1u; nx = cnt > 0u ? cnt : 1u;
}

__device__ __forceinline__ void xcd_barrier(const XcdBarrier& b) {
    asm volatile("s_waitcnt vmcnt(0)" ::: "memory");
    __syncthreads();
    if (threadIdx.x == 0) {
        unsigned* bar = b.bar;
        __builtin_amdgcn_s_waitcnt(0);
        unsigned nloc = b.st[0], nx = b.st[1];
        if (nloc == 0u) { xcd_barrier_complete(bar, b.x, nloc, nx); b.st[0] = nloc; b.st[1] = nx; }
        const unsigned old = xb_add(&bar[XB_XSUB(b.x)], 1u);
        const unsigned gen = old / nloc;
        if (old + 1u == (gen + 1u) * nloc) {
            __builtin_amdgcn_fence(__ATOMIC_RELEASE, "agent");
            asm volatile("s_waitcnt vmcnt(0)" ::: "memory");
            const unsigned og = xb_add(&bar[XB_TOP], 1u);
            const unsigned tg = og / nx;
            if (og + 1u == (tg + 1u) * nx) xb_add(&bar[XB_TOPGEN], 1u);
            else XB_SPIN(xb_ld(&bar[XB_TOPGEN]) == tg, bar);
            __builtin_amdgcn_fence(__ATOMIC_ACQUIRE, "agent");
            xb_add(&bar[XB_XGEN(b.x)], 1u);
            asm volatile("s_waitcnt vmcnt(0)" ::: "memory");
        } else {
            XB_SPIN(xb_ld(&bar[XB_XGEN(b.x)]) == gen, bar);
            __builtin_amdgcn_fence(__ATOMIC_ACQUIRE, "agent");
            asm volatile("s_waitcnt vmcnt(0)" ::: "memory");
        }
    }
    __syncthreads();
}

enum { T_SKIP = 0, T_NORM, T_UP, T_RES, T_PLAIN, T_ELT_A1, T_ELT_A2, T_ELT_B, T_ATTN };

__global__ void __launch_bounds__(512, 2) fwd_mega(KP p, int ph_lo, int ph_hi) {
    extern __shared__ __attribute__((aligned(16))) unsigned char lds_raw[];
    cg::grid_group grid = cg::this_grid();
    LAS unsigned char* lds = (LAS unsigned char*)lds_raw;
    const int G = gridDim.x, NGW = G * 8;
    unsigned char* ws = p.ws;
    bf16_t* Wb = (bf16_t*)(ws + WS_W); bf16_t* XN = (bf16_t*)(ws + WS_XN); float* XC = (float*)(ws + WS_XC); float* MOD = (float*)(ws + WS_MOD);
    unsigned char* tmp = ws + WS_TMP;
    int phase = 0, repc = 0;
    for (int u_ = threadIdx.x; u_ < (LDS_BYTES - 131072) / 4; u_ += 512) ((LAS unsigned*)(lds + 131072))[u_] = 0u;
    __syncthreads();
    (void)xcd_barrier_post((unsigned*)ws + 4096, (volatile LAS unsigned*)(lds + 131072 + 320) + 8);
#define SEAM() do { ++phase; if (phase > ph_lo && phase < ph_hi) { if (phase == 1) grid.sync(); else { XcdBarrier bar_; bar_.bar = (unsigned*)KARGS()->ws + 4096; bar_.x = xb_xcc_id(); bar_.st = (volatile LAS unsigned*)(lds + 131072 + 320) + 8; xcd_barrier(bar_); } } } while (0)
#define ACTIVE() (phase >= ph_lo && phase < ph_hi)
#if EN & 64
    for (int rep_ = 0; rep_ < REP_PRO; ++rep_) {
    if (ACTIVE()) { int tl_ = threadIdx.x; asm volatile("" : "+v"(tl_)); prologue_phase(p, lds, tl_, tl_ & 63, __builtin_amdgcn_readfirstlane(tl_ >> 6), G); }
    SEAM(); }
#else
    SEAM();
#endif
    for (int rep_ = 0; rep_ < REP_PRE; ++rep_) {
    if (ACTIVE()) { int tl_ = threadIdx.x; asm volatile("" : "+v"(tl_)); pre_phase(p, lds, tl_, tl_ & 63, __builtin_amdgcn_readfirstlane(tl_ >> 6), G); }
    SEAM(); }
    for (int l = 0; l < DEPTH; ++l) {
        const int kind = l % 3, jm = l / 3;
        const float* modl = MOD + (size_t)l * 9 * 9216;
        bf16_t* WL = Wb + (size_t)l * W_LAYER;
        for (int s = 0; s < 13; ++s) {
            int type;
            switch (s) {
            case 1: case 11: type = T_UP; break;
            case 2: case 9: case 12: type = T_RES; break;
            case 4: type = T_PLAIN; break;
            case 5: type = kind == 0 ? T_ELT_A1 : (kind == 1 ? T_ELT_B : T_SKIP); break;
            case 6: type = kind == 0 ? T_PLAIN : T_SKIP; break;
            case 8: type = T_ATTN; break;
            default: type = T_SKIP; break;
            }
            if (type == T_SKIP) continue;
            if (ACTIVE()) {
                int tl_ = threadIdx.x; asm volatile("" : "+v"(tl_)); const int lane = tl_ & 63; const int gw = blockIdx.x * 8 + __builtin_amdgcn_readfirstlane(tl_ >> 6);
                switch (type) {
#if EN & 2
                case T_UP: { const int half = s == 1 ? 0 : 1;
                    const int Mrows = (l == DEPTH - 1 && half) ? ML : MT;
                    pg8::Gemm g{half ? (const bf16_t*)(tmp + T_XG2) : XN, WL + (half ? W_13B : W_13A), Mrows, 2 * DFF, DM}; pg8::StaticOrder S; S.init(Mrows, 2 * DFF, G, (int)blockIdx.x, DM, 0);
                    pg8::EpiSwiglu E{l, half};
                    pg8::gemm_phase<pg8::EpiSwiglu, pg8::StaticOrder, true, true>(lds, g, S, E); } break;
#endif
#if EN & 4
                case T_RES: { const bf16_t* gA; const bf16_t* gB; int gK;
                    if (s == 9) { gA = XN; gK = 1024; gB = kind == 0 ? Wb + W_MX + (size_t)jm * W_ASZ + W_A_O : (kind == 1 ? Wb + W_MXB + W_B_O : Wb + W_MXC + W_C_O); }
                    else { gA = (const bf16_t*)(tmp + T_ACT); gK = DFF; gB = WL + (s == 2 ? W_2A : W_2B); }
                    const int Mrows = (l == DEPTH - 1 && s >= 9) ? ML : MT;
                    pg8::Gemm g{gA, gB, Mrows, DM, gK}; pg8::StaticOrder S; S.init(Mrows, DM, G, (int)blockIdx.x, gK, 0);
                    pg8::EpiRes E{l, s | (repc > 0 ? 16 : 0)};
                    pg8::gemm_phase<pg8::EpiRes, pg8::StaticOrder, true, true>(lds, g, S, E); } break;
#endif
#if EN & 8
                case T_PLAIN: {
                    const int ngem = s == 6 ? 2 : 1;
                    for (int gi = 0; gi < ngem; ++gi) {
                        const bf16_t* gA; const bf16_t* gB; int gN, gK; bf16_t* gO; int ssidx = -1;
                        if (s == 4) { gA = XN; gK = 1024; ssidx = l * 3 + 1;
                            if (kind == 0)      { gB = Wb + W_MX + (size_t)jm * W_ASZ + W_A_IN; gN = 768; gO = (bf16_t*)(tmp + T_APROJ); }
                            else if (kind == 1) { gB = Wb + W_MXB + W_B_QKV; gN = 1536; gO = (bf16_t*)(tmp + T_PROJ); }
                            else                { gB = Wb + W_MXC + W_C_QKV; gN = 3072; gO = (bf16_t*)(tmp + T_PROJ); } }
                        else if (gi == 0) { gA = (const bf16_t*)(tmp + T_ACQN); gB = Wb + W_MX + (size_t)jm * W_ASZ + W_A_UQ; gN = 1536; gK = 384; gO = (bf16_t*)(tmp + T_AQ); }
                        else { gA = (const bf16_t*)(tmp + T_ACKVN); gB = Wb + W_MX + (size_t)jm * W_ASZ + W_A_UKV; gN = 2048; gK = 256; gO = (bf16_t*)(tmp + T_AKV); }
                        const int Mrows = (l == DEPTH - 1 && s == 6 && gi == 0) ? ML : MT;
                        pg8::Gemm g{gA, gB, Mrows, gN, gK}; pg8::StaticOrder S; S.init(Mrows, gN, G, (int)blockIdx.x, gK, 0);
                        pg8::EpiBf16N E{gO, gN, ssidx, l};
                        pg8::gemm_phase<pg8::EpiBf16N, pg8::StaticOrder, true, true>(lds, g, S, E);
                        __syncthreads();
                    } } break;
#endif
#if EN & 16
                case T_ELT_A1: mla_norm_phase((const bf16_t*)(tmp + T_APROJ), p.in[12] + (size_t)jm * 384, p.in[13] + (size_t)jm * 256,
                                              (bf16_t*)(tmp + T_ACQN), (bf16_t*)(tmp + T_ACKVN), (bf16_t*)(tmp + T_AKR), gw, NGW, lane); break;
                case T_ELT_A2: mla_qrope_phase((bf16_t*)(tmp + T_AQ), gw, NGW, lane); break;
                case T_ELT_B: gqa_normrope_phase((bf16_t*)(tmp + T_PROJ), p.in[18] + (size_t)jm * 128, p.in[19] + (size_t)jm * 128, gw, NGW, lane); break;
#endif
#if EN & 32
                case T_ATTN: attn_phase(kind, p, jm, (char*)lds_raw, G, l < DEPTH - 1); break;
#endif
                default: break;
                }
            }
            SEAM();
            { const int nrep_ = (type == T_ATTN) ? REP_ATTN : (type == T_UP) ? REP_UP : (type == T_PLAIN) ? REP_PLAIN : (type == T_ELT_A1) ? REP_A1 : (type == T_RES && l == 0 && s == 2) ? REP_RES0 : 1;
              if (repc + 1 < nrep_) { ++repc; --s; } else repc = 0; }
        }
    }
    for (int es_ = 0; es_ < EXTRA_SYNCS; ++es_) { XcdBarrier bar_; bar_.bar = (unsigned*)KARGS()->ws + 4096; bar_.x = xb_xcc_id(); bar_.st = (volatile LAS unsigned*)(lds + 131072 + 320) + 8; xcd_barrier(bar_); }
    if (ACTIVE()) { int tl_ = threadIdx.x; asm volatile("" : "+v"(tl_)); final_norm_phase(p.out, p.in[24], blockIdx.x * 8 + __builtin_amdgcn_readfirstlane(tl_ >> 6), NGW, tl_ & 63); }
#undef SEAM
#undef ACTIVE
}

extern "C" void kernel_launch(void* const* d_in, const int* in_sizes, int n_in, void* d_out, int out_size, void* d_ws, size_t ws_size, hipStream_t stream) {
    static int grid = 0;
    if (grid == 0) {
        if (n_in != 25 || out_size != ML * DM || ws_size < WS_END) { fprintf(stderr, "kernel_launch: unexpected shapes: n_in %d out %d ws %zu (need %zu)\n", n_in, out_size, ws_size, (size_t)WS_END); grid = -1; return; }
        int dev = 0, cus = 0, per_cu = 0;
        hipGetDevice(&dev); hipDeviceGetAttribute(&cus, hipDeviceAttributeMultiprocessorCount, dev);
        if (hipFuncSetAttribute((const void*)fwd_mega, hipFuncAttributeMaxDynamicSharedMemorySize, LDS_BYTES) != hipSuccess) { fprintf(stderr, "kernel_launch: hipFuncSetAttribute failed\n"); grid = -1; return; }
        if (hipOccupancyMaxActiveBlocksPerMultiprocessor(&per_cu, (const void*)fwd_mega, 512, LDS_BYTES) != hipSuccess || per_cu < 1) { fprintf(stderr, "kernel_launch: occupancy query says %d\n", per_cu); per_cu = 1; }
        (void)hipGetLastError();
        grid = cus;
        fprintf(stderr, "kernel_launch: grid %d (cus %d, per_cu %d)\n", grid, cus, per_cu);
    }
    if (grid < 0) return;
    KP p{};
    for (int i = 0; i < 25; ++i) p.in[i] = (const float*)d_in[i];
    p.out = (float*)d_out; p.ws = (unsigned char*)d_ws;
    if (hipMemsetAsync(d_ws, 0, 1u << 20, stream) != hipSuccess) { fprintf(stderr, "kernel_launch: hipMemsetAsync failed\n"); return; }
    int lo = 0, hi = 1 << 30;
    void* args[] = {&p, &lo, &hi};
    hipError_t e = hipLaunchCooperativeKernel((const void*)fwd_mega, dim3(grid), dim3(512), args, LDS_BYTES, stream);
    if (e != hipSuccess) fprintf(stderr, "cooperative launch failed: %s (grid %d)\n", hipGetErrorString(e), grid);
}
```
